# Optimizing an MI355X kernel written in HIP

```python
import math
import jax, jax.numpy as jnp
from jax import lax
import numpy as np

D_MODEL = 1024
BATCH = 8
SEQ = 2048
DEPTH = 1

CHUNK = 64
N_META = 16
META_PAD = CHUNK - N_META

GDN_HEADS = 8
GDN_DK = 128
GDN_DV = 128
GDN_CONV = 4
GDN_QK_W = GDN_HEADS * GDN_DK
GDN_V_W = GDN_HEADS * GDN_DV

SWA_HEADS = 16
SWA_KV_HEADS = 4
SWA_GROUPS = SWA_HEADS // SWA_KV_HEADS
SWA_HD = 64
SWA_Q_W = SWA_HEADS * SWA_HD
SWA_KV_W = SWA_KV_HEADS * SWA_HD
WINDOW = 128
WINDOW_CHUNKS = WINDOW // CHUNK

N_BRANCH = 2
IN_WIDTHS = (GDN_QK_W, GDN_QK_W, GDN_V_W, GDN_V_W, GDN_HEADS, GDN_HEADS,
             SWA_Q_W, SWA_KV_W, SWA_KV_W, SWA_Q_W, D_MODEL, D_MODEL)
IN_VALUE_SEGMENTS = (2, 8)

DEEPNORM_ALPHA = (2.0 * DEPTH) ** 0.25
DEEPNORM_BETA = (8.0 * DEPTH) ** -0.25
LN_EPS = 1e-5
RMS_EPS = 1e-6
L2_EPS = 1e-6

kernel_name = "hybrid_gdn_swa_sink_alibi_metatoken_deepnorm"


def layer_norm(x, w, b):
    xf = x.astype(jnp.float32)
    mu = jnp.mean(xf, axis=-1, keepdims=True)
    var = jnp.mean(jnp.square(xf - mu), axis=-1, keepdims=True)
    y = (xf - mu) * lax.rsqrt(var + LN_EPS) * w.astype(jnp.float32) + b.astype(jnp.float32)
    return y.astype(x.dtype)


def l2_normalize(x):
    return x * lax.rsqrt(jnp.sum(jnp.square(x), axis=-1, keepdims=True) + L2_EPS)


def causal_depthwise_conv(x, w):
    ch = x.shape[-1]
    return lax.conv_general_dilated(
        x, w[:, None, :].astype(x.dtype), window_strides=(1,),
        padding=[(GDN_CONV - 1, 0)], dimension_numbers=('NWC', 'WIO', 'NWC'),
        feature_group_count=ch)


def alibi_slopes(n_heads):
    return jnp.exp2(-8.0 * jnp.arange(1, n_heads + 1, dtype=jnp.float32) / n_heads)


def gated_deltanet(q, k, v, beta_raw, a_raw, conv_w, a_log, dt_bias):
    f32 = jnp.float32
    b, L, _ = q.shape
    qkv = jax.nn.silu(causal_depthwise_conv(jnp.concatenate([q, k, v], axis=-1), conv_w))
    q, k, v = jnp.split(qkv.astype(f32), [GDN_QK_W, 2 * GDN_QK_W], axis=-1)
    q = l2_normalize(q.reshape(b, L, GDN_HEADS, GDN_DK)) * (GDN_DK ** -0.5)
    k = l2_normalize(k.reshape(b, L, GDN_HEADS, GDN_DK))
    v = v.reshape(b, L, GDN_HEADS, GDN_DV)
    beta = jax.nn.sigmoid(beta_raw.astype(f32))
    g = -jnp.exp(a_log.astype(f32)) * jax.nn.softplus(a_raw.astype(f32) + dt_bias.astype(f32))

    pad4 = ((0, 0), (META_PAD, 0), (0, 0), (0, 0))
    pad3 = ((0, 0), (META_PAD, 0), (0, 0))
    q, k, v = jnp.pad(q, pad4), jnp.pad(k, pad4), jnp.pad(v, pad4)
    beta, g = jnp.pad(beta, pad3), jnp.pad(g, pad3)
    n_ch = (L + META_PAD) // CHUNK

    def to_chunks(t):
        return t.reshape(b, n_ch, CHUNK, GDN_HEADS, -1).transpose(0, 3, 1, 2, 4)

    q, k, v = to_chunks(q), to_chunks(k), to_chunks(v)
    beta = beta.reshape(b, n_ch, CHUNK, GDN_HEADS).transpose(0, 3, 1, 2)
    g_cum = jnp.cumsum(g.reshape(b, n_ch, CHUNK, GDN_HEADS).transpose(0, 3, 1, 2), axis=-1)

    tri = jnp.tril(jnp.ones((CHUNK, CHUNK), dtype=bool))
    strict = jnp.tril(jnp.ones((CHUNK, CHUNK), dtype=bool), k=-1)
    decay = jnp.exp(jnp.where(tri, g_cum[..., :, None] - g_cum[..., None, :], -jnp.inf))

    k_beta = k * beta[..., None]
    v_beta = v * beta[..., None]
    lower = jnp.where(strict, jnp.einsum('bhnid,bhnjd->bhnij', k_beta, k) * decay, 0.0)
    rhs = jnp.concatenate([v_beta, k_beta * jnp.exp(g_cum)[..., None]], axis=-1)
    sol = lax.linalg.triangular_solve(lower + jnp.eye(CHUNK, dtype=f32), rhs,
                                      left_side=True, lower=True, unit_diagonal=True)
    u, w = sol[..., :GDN_DV], sol[..., GDN_DV:]
    attn = jnp.einsum('bhnid,bhnjd->bhnij', q, k) * decay
    q_dec = q * jnp.exp(g_cum)[..., None]
    k_dec = k * jnp.exp(g_cum[..., -1:] - g_cum)[..., None]
    g_last = jnp.exp(g_cum[..., -1])

    def step(S, inp):
        u_c, w_c, attn_c, q_c, k_c, gl_c = inp
        v_new = u_c - jnp.einsum('bhik,bhkv->bhiv', w_c, S)
        o_c = jnp.einsum('bhik,bhkv->bhiv', q_c, S) + jnp.einsum('bhij,bhjv->bhiv', attn_c, v_new)
        S = S * gl_c[..., None, None] + jnp.einsum('bhik,bhiv->bhkv', k_c, v_new)
        return S, o_c

    xs = tuple(jnp.moveaxis(t, 2, 0) for t in (u, w, attn, q_dec, k_dec, g_last))
    S0 = jnp.zeros((b, GDN_HEADS, GDN_DK, GDN_DV), f32)
    _, o = lax.scan(step, S0, xs)
    o = o.transpose(1, 0, 3, 2, 4).reshape(b, n_ch * CHUNK, GDN_HEADS, GDN_DV)
    return o[:, META_PAD:]


def sliding_window_sink_attention(q, k, v, sinks):
    f32 = jnp.float32
    b, L, _ = q.shape
    n_ch = (L + META_PAD) // CHUNK
    pad = ((0, 0), (META_PAD, 0), (0, 0))
    q = jnp.pad(q, pad).reshape(b, n_ch, CHUNK, SWA_KV_HEADS, SWA_GROUPS, SWA_HD).transpose(0, 3, 4, 1, 2, 5)
    k = jnp.pad(k, pad).reshape(b, n_ch, CHUNK, SWA_KV_HEADS, SWA_HD).transpose(0, 3, 1, 2, 4)
    v = jnp.pad(v, pad).reshape(b, n_ch, CHUNK, SWA_KV_HEADS, SWA_HD).transpose(0, 3, 1, 2, 4)

    def band(t):
        meta = jnp.broadcast_to(t[:, :, :1, META_PAD:], (b, SWA_KV_HEADS, n_ch, N_META, SWA_HD))
        tp = jnp.pad(t, ((0, 0), (0, 0), (WINDOW_CHUNKS, 0), (0, 0), (0, 0)))
        shifted = [tp[:, :, j:j + n_ch] for j in range(WINDOW_CHUNKS + 1)]
        return jnp.concatenate([meta] + shifted, axis=3)

    k_w, v_w = band(k), band(v)
    scores = jnp.einsum('bkgncd,bknsd->bkgncs', q, k_w).astype(f32) * (SWA_HD ** -0.5)

    c_idx = jnp.arange(n_ch)[:, None]
    t_q = c_idx * CHUNK + jnp.arange(CHUNK)[None, :] - META_PAD
    off = jnp.arange((WINDOW_CHUNKS + 1) * CHUNK)[None, :]
    key_chunk = c_idx - WINDOW_CHUNKS + off // CHUNK
    t_band = key_chunk * CHUNK + off % CHUNK - META_PAD
    t_k = jnp.concatenate([jnp.broadcast_to(jnp.arange(N_META)[None, :], (n_ch, N_META)), t_band], axis=1)
    valid = jnp.concatenate([jnp.ones((n_ch, N_META), dtype=bool), key_chunk >= 1], axis=1)
    dist = jnp.abs(t_q[:, :, None] - t_k[:, None, :]).astype(f32)

    slopes = alibi_slopes(SWA_HEADS).reshape(SWA_KV_HEADS, SWA_GROUPS)
    scores = scores - slopes[:, :, None, None, None] * dist
    scores = jnp.where(valid[:, None, :], scores, -jnp.inf)
    sink = jnp.broadcast_to(sinks.astype(f32).reshape(SWA_KV_HEADS, SWA_GROUPS, 1, 1, 1),
                            scores.shape[:-1] + (1,))
    probs = jax.nn.softmax(jnp.concatenate([scores, sink], axis=-1), axis=-1)[..., :-1]
    o = jnp.einsum('bkgncs,bknsd->bkgncd', probs.astype(v_w.dtype), v_w)
    o = o.transpose(0, 3, 4, 1, 2, 5).reshape(b, n_ch * CHUNK, SWA_Q_W)
    return o[:, META_PAD:]


def hybrid_layer(h, w_in, b_gate, conv_w, a_log, dt_bias, gdn_norm_w, sinks,
                 w_proj_a, w_proj_b, w_out, ln_w, ln_b):
    b, L, _ = h.shape
    offsets, acc = [], 0
    for wd in IN_WIDTHS[:-1]:
        acc += wd
        offsets.append(acc)
    (q_a, k_a, v_a, z_a, beta_a, dec_a, q_b, k_b, v_b, z_b, gate_a, gate_b) = jnp.split(
        h @ w_in, offsets, axis=-1)

    o_a = gated_deltanet(q_a, k_a, v_a, beta_a, dec_a, conv_w, a_log, dt_bias)
    o_a = o_a * lax.rsqrt(jnp.mean(jnp.square(o_a), axis=-1, keepdims=True) + RMS_EPS) * gdn_norm_w.astype(jnp.float32)
    y_a = (o_a.reshape(b, L, GDN_V_W) * jax.nn.silu(z_a.astype(jnp.float32))).astype(h.dtype)

    y_b = sliding_window_sink_attention(q_b, k_b, v_b, sinks) * jax.nn.silu(z_b)

    g_a = jax.nn.sigmoid(gate_a + b_gate[:D_MODEL])
    g_b = jax.nn.sigmoid(gate_b + b_gate[D_MODEL:])
    mixed = g_a * (y_a @ w_proj_a) + g_b * (y_b @ w_proj_b)
    out = mixed @ w_out
    return layer_norm(DEEPNORM_ALPHA * h + out, ln_w, ln_b)


def setup_inputs(seed: int = 0) -> dict:
    key = jax.random.key(seed)
    ks = jax.random.split(key, 16)
    f32 = jnp.float32
    x = jax.random.normal(ks[0], (BATCH, SEQ, D_MODEL), f32)
    meta_tokens = jax.random.normal(ks[1], (N_META, D_MODEL), f32)
    seg_keys = jax.random.split(ks[2], len(IN_WIDTHS))
    segs = []
    for i, (sk, wd) in enumerate(zip(seg_keys, IN_WIDTHS)):
        scale = D_MODEL ** -0.5 * (DEEPNORM_BETA if i in IN_VALUE_SEGMENTS else 1.0)
        segs.append(jax.random.normal(sk, (DEPTH, D_MODEL, wd), f32) * scale)
    w_in = jnp.concatenate(segs, axis=2)
    b_gate = 0.01 * jax.random.normal(ks[3], (DEPTH, N_BRANCH * D_MODEL), f32)
    conv_w = jax.random.normal(ks[4], (DEPTH, GDN_CONV, 2 * GDN_QK_W + GDN_V_W), f32) * (GDN_CONV ** -0.5)
    a_log = jnp.log(jax.random.uniform(ks[5], (DEPTH, GDN_HEADS), f32, minval=1.0, maxval=16.0))
    dt = jnp.exp(jax.random.uniform(ks[6], (DEPTH, GDN_HEADS), f32,
                                    minval=math.log(1e-3), maxval=math.log(1e-1)))
    dt_bias = dt + jnp.log(-jnp.expm1(-dt))
    gdn_norm_w = 1.0 + 0.02 * jax.random.normal(ks[7], (DEPTH, GDN_DV), f32)
    sinks = jax.random.normal(ks[8], (DEPTH, SWA_HEADS), f32)
    w_proj_a = jax.random.normal(ks[9], (DEPTH, GDN_V_W, D_MODEL), f32) * (GDN_V_W ** -0.5 * DEEPNORM_BETA)
    w_proj_b = jax.random.normal(ks[10], (DEPTH, SWA_Q_W, D_MODEL), f32) * (SWA_Q_W ** -0.5 * DEEPNORM_BETA)
    w_out = jax.random.normal(ks[11], (DEPTH, D_MODEL, D_MODEL), f32) * (D_MODEL ** -0.5 * DEEPNORM_BETA)
    ln_w = 1.0 + 0.02 * jax.random.normal(ks[12], (DEPTH, D_MODEL), f32)
    ln_b = 0.02 * jax.random.normal(ks[13], (DEPTH, D_MODEL), f32)
    return {"x": x, "meta_tokens": meta_tokens, "w_in": w_in, "b_gate": b_gate,
            "conv_w": conv_w, "a_log": a_log, "dt_bias": dt_bias, "gdn_norm_w": gdn_norm_w,
            "sinks": sinks, "w_proj_a": w_proj_a, "w_proj_b": w_proj_b, "w_out": w_out,
            "ln_w": ln_w, "ln_b": ln_b}


def reference(x, meta_tokens, w_in, b_gate, conv_w, a_log, dt_bias, gdn_norm_w, sinks,
              w_proj_a, w_proj_b, w_out, ln_w, ln_b):
    b = x.shape[0]
    meta = jnp.broadcast_to(meta_tokens.astype(x.dtype)[None], (b, N_META, D_MODEL))
    h = jnp.concatenate([meta, x], axis=1)
    for l in range(DEPTH):
        h = hybrid_layer(h, w_in[l], b_gate[l], conv_w[l], a_log[l], dt_bias[l], gdn_norm_w[l],
                         sinks[l], w_proj_a[l], w_proj_b[l], w_out[l], ln_w[l], ln_b[l])
    return h[:, N_META:]
```

```cpp
#include <hip/hip_runtime.h>
#include <hip/hip_cooperative_groups.h>
#include <cstdio>
#include <cstdint>
namespace cg = cooperative_groups;

#define LAS __attribute__((address_space(3)))
typedef unsigned short bf16_t;
typedef short bf16x8 __attribute__((ext_vector_type(8)));
typedef short bf16x4 __attribute__((ext_vector_type(4)));
typedef float f32x4 __attribute__((ext_vector_type(4)));
typedef float f32x2 __attribute__((ext_vector_type(2)));
typedef unsigned u32x4 __attribute__((ext_vector_type(4)));
typedef unsigned u32x2 __attribute__((ext_vector_type(2)));

constexpr int NB = 8, SEQ = 2048, DM = 1024, LP = 2112, NCH = 33, MP = NB * LP  , MR = NB * SEQ  ;
constexpr int NWIN = 8720;
constexpr float DN_ALPHA = 1.189207115002721f;
constexpr float LOG2E = 1.4426950408889634f;

constexpr size_t SZ_S1 = (size_t)MP * 1024 * 2;
constexpr size_t WS_WT1 = 0;
constexpr size_t WS_WT2 = WS_WT1 + (size_t)4608 * 1024 * 2;
constexpr size_t WS_WA = WS_WT2 + (size_t)4096 * 1024 * 2;
constexpr size_t WS_WB = WS_WA + (size_t)1024 * 1024 * 2;
constexpr size_t WS_WO = WS_WB + (size_t)1024 * 1024 * 2;
constexpr size_t WS_BD = WS_WO + (size_t)1024 * 1024 * 2;
constexpr size_t WS_GL = WS_BD + (size_t)MP * 16 * 4;
constexpr size_t WS_SSQ = WS_GL + 16384;
constexpr size_t WS_HALO = WS_SSQ + (size_t)MP * 64 * 4;
constexpr size_t WS_QA = WS_HALO + (size_t)264 * 3 * 3072 * 2;
constexpr size_t WS_KA = WS_QA + SZ_S1;
constexpr size_t WS_VA = WS_KA + SZ_S1;
constexpr size_t WS_QB = WS_VA + SZ_S1;
constexpr size_t WS_KVB = WS_QB + SZ_S1;
constexpr size_t WS_WBUF = WS_KVB + (size_t)MP * 512 * 2;
constexpr size_t WS_ATT = WS_WBUF + SZ_S1;
constexpr size_t WS_END = WS_ATT + (size_t)2112 * 4096 * 2;
constexpr size_t WS_CTL = WS_END;
constexpr size_t CTL_BYTES = 16384;
static_assert(WS_CTL + CTL_BYTES <= 268435456 && WS_CTL % 256 == 0, "workspace map");

constexpr int LDS_BYTES = 147456;

typedef __bf16 bf16x2_t __attribute__((ext_vector_type(2)));
__device__ __forceinline__ unsigned cvt_pk_bf16(float lo, float hi) { const f32x2 v = {lo, hi}; return __builtin_bit_cast(unsigned, __builtin_convertvector(v, bf16x2_t)); }
__device__ __forceinline__ float bf_lo(unsigned w) { return __uint_as_float(w << 16); }
__device__ __forceinline__ float bf_hi(unsigned w) { return __uint_as_float(w & 0xffff0000u); }
__device__ __forceinline__ float bf2f(bf16_t b) { return __uint_as_float(((unsigned)b) << 16); }
__device__ __forceinline__ float sigmoidf_(float x) { return __builtin_amdgcn_rcpf(1.f + __expf(-x)); }
__device__ __forceinline__ float siluf_(float x) { return x * sigmoidf_(x); }
__device__ __forceinline__ float wave_sum(float v) {
#pragma unroll
    for (int o = 1; o < 64; o <<= 1) v += __shfl_xor(v, o);
    return v;
}
__device__ __forceinline__ float wave_sum_dpp(float v) {
    v += __builtin_bit_cast(float, __builtin_amdgcn_update_dpp(0, __builtin_bit_cast(int, v), 0xB1, 0xF, 0xF, true));
    v += __builtin_bit_cast(float, __builtin_amdgcn_update_dpp(0, __builtin_bit_cast(int, v), 0x4E, 0xF, 0xF, true));
    v += __builtin_bit_cast(float, __builtin_amdgcn_update_dpp(0, __builtin_bit_cast(int, v), 0x141, 0xF, 0xF, true));
    v += __builtin_bit_cast(float, __builtin_amdgcn_update_dpp(0, __builtin_bit_cast(int, v), 0x140, 0xF, 0xF, true));
    const int vi = __builtin_bit_cast(int, v);
    return (__builtin_bit_cast(float, __builtin_amdgcn_readlane(vi, 0)) + __builtin_bit_cast(float, __builtin_amdgcn_readlane(vi, 16)))
         + (__builtin_bit_cast(float, __builtin_amdgcn_readlane(vi, 32)) + __builtin_bit_cast(float, __builtin_amdgcn_readlane(vi, 48)));
}
#define LDS_WAIT() asm volatile("s_waitcnt lgkmcnt(0)" ::: "memory")

namespace pg8 {
constexpr int BM = 256, BK = 64, HALF = 128, HTB = HALF * BK * 2, STAGE_BYTES = 8 * HTB, NXCD = 8, WGM = 8;
__host__ __device__ __forceinline__ int lds_byte(int r, int c) { const int st = (r >> 4) * 2 + (c >> 5), rr = r & 15, cc = c & 31, ob = rr * 64 + cc * 2; return st * 1024 + (ob ^ (((ob >> 9) & 1) << 5)); }
__host__ __device__ __forceinline__ void stage_rc(int b, int& R, int& C) { const int st = b / 1024, sb = b % 1024, swz = sb ^ (((sb >> 9) & 1) << 5); R = (st >> 1) * 16 + swz / 64; C = (st & 1) * 32 + (swz % 64) / 2; }
__host__ __device__ __forceinline__ int perm32(int rho) { const int n = rho >> 4, i = rho & 15; return 8 * (i >> 2) + 4 * n + (i & 3); }
struct Unit { int pm, pn; };
struct Gemm { const bf16_t* A; const bf16_t* Bt; int M, N, K, amode; const bf16_t* A2; int lda, split;
    __device__ __forceinline__ size_t aoffs(int pm) const { const int r = amode ? ((pm >> 3) * LP + 64 + (pm & 7) * 256) : pm * 256; return (size_t)r * lda * 2; } };
struct StaticOrder {
    int nM, nN, nwg, G, c;
    __host__ __device__ void init(int M, int N, int G_, int c_) { nM = M / BM; nN = N / BM; nwg = nM * nN; G = G_; c = c_; }
    __host__ __device__ bool next(int i, Unit& u) const {
        const long L = (long)i * G + c; if (L >= nwg) return false;
        int wgid = (int)L; { const int q = nwg / NXCD, r = nwg % NXCD, xcd = wgid % NXCD, off = wgid / NXCD; wgid = (xcd < r ? xcd * (q + 1) : r * (q + 1) + (xcd - r) * q) + off; }
        const int nig = WGM * nN, gid = wgid / nig, fm = gid * WGM, gsz = (nM - fm) < WGM ? (nM - fm) : WGM;
        u.pm = fm + ((wgid % nig) % gsz); u.pn = (wgid % nig) / gsz; return true;
    }
};
template <class Epi, bool ALIGN_EPI>
__device__ __forceinline__ void gemm_phase(LAS unsigned char* lds, const Gemm g, const StaticOrder& S, const Epi& E) {
    int tid = threadIdx.x; asm volatile("" : "+v"(tid));
    const int wid = __builtin_amdgcn_readfirstlane(tid >> 6), lane = tid & 63, wr = wid >> 2, wc = wid & 3, fr = lane & 15, fq = lane >> 4;
    const int K = g.K, nt = K / BK;
    unsigned voffA[2], voffB[2];
#pragma unroll
    for (int i = 0; i < 2; ++i) { int R, C; stage_rc(tid * 16 + i * 8192, R, C); const int Rb = (R & ~31) + perm32(R & 31);
        voffA[i] = (unsigned)(R * g.lda + C) * 2u; voffB[i] = (unsigned)(Rb * K + C) * 2u; }
    const size_t kstep = (size_t)(BK * 2);
    const size_t hstep = (size_t)HALF * K * 2;
    const size_t hstepA = (size_t)HALF * g.lda * 2;
    const size_t tstep = 2 * hstep;
    const int split = g.split; const ptrdiff_t a2d = ((const char*)g.A2 - (const char*)g.A) - (ptrdiff_t)split * (ptrdiff_t)kstep;
#define PG8_AK(base, t) ((base) + ((t) < split ? (ptrdiff_t)0 : a2d) + (size_t)(t) * kstep)
    const unsigned ldsw = (unsigned)wid * 1024u;
    const int aoff = lds_byte(wr * 64 + fr, fq * 8), boff = lds_byte(wc * 32 + fr, fq * 8);
#define PG8_SA(b, h) (((b) * 2 + (h)) * HTB)
#define PG8_SB(b, h) ((4 + (b) * 2 + (h)) * HTB)
#define PG8_STAGE(bufoff, gbase, voff) do { _Pragma("unroll") for (int _i = 0; _i < 2; ++_i) \
        __builtin_amdgcn_global_load_lds((const unsigned*)((const char*)(gbase) + (voff)[_i]), (LAS unsigned*)(lds + (bufoff) + ldsw + _i * 8192), 16, 0, 0); } while (0)
#define PG8_LDA(dst, b, h) do { _Pragma("unroll") for (int m = 0; m < 4; ++m) _Pragma("unroll") for (int k = 0; k < 2; ++k) dst[m][k] = *(const LAS bf16x8*)(lds + PG8_SA(b, h) + aoff + m * 2048 + k * 1024); } while (0)
#define PG8_LDB(dst, b, h) do { _Pragma("unroll") for (int n = 0; n < 2; ++n) _Pragma("unroll") for (int k = 0; k < 2; ++k) dst[n][k] = *(const LAS bf16x8*)(lds + PG8_SB(b, h) + boff + n * 2048 + k * 1024); } while (0)
#define PG8_MMA(ai, bj, At, Bt) do { __builtin_amdgcn_s_setprio(1); _Pragma("unroll") for (int m = 0; m < 4; ++m) _Pragma("unroll") for (int n = 0; n < 2; ++n) _Pragma("unroll") for (int k = 0; k < 2; ++k) \
        acc[ai][bj][m][n] = __builtin_amdgcn_mfma_f32_16x16x32_bf16(Bt[n][k], At[m][k], acc[ai][bj][m][n], 0, 0, 0); __builtin_amdgcn_s_setprio(0); } while (0)
#define PG8_WAIT_V(n) asm volatile("s_waitcnt vmcnt(" #n ")" ::: "memory")
#define PG8_WAIT_L(n) asm volatile("s_waitcnt lgkmcnt(" #n ")" ::: "memory")
#define PG8_BAR __builtin_amdgcn_s_barrier()
#define PG8_SCHED __builtin_amdgcn_sched_barrier(0)
    Unit cur, nxt; int ui = 0;
    if (!S.next(0, cur)) return;
    f32x4 acc[2][2][4][2];
#pragma unroll
    for (int a = 0; a < 2; ++a)
#pragma unroll
        for (int b = 0; b < 2; ++b)
#pragma unroll
            for (int m = 0; m < 4; ++m)
#pragma unroll
                for (int n = 0; n < 2; ++n) acc[a][b][m][n] = (f32x4){0.f, 0.f, 0.f, 0.f};
    bf16x8 At[4][2], B0[2][2], B1[2][2];
    const char* cA = (const char*)g.A + g.aoffs(cur.pm); const char* cB = (const char*)g.Bt + (size_t)cur.pn * tstep;
    PG8_STAGE(PG8_SB(0, 0), cB, voffB); PG8_STAGE(PG8_SB(0, 1), cB + hstep, voffB); PG8_STAGE(PG8_SA(0, 0), cA, voffA); PG8_STAGE(PG8_SA(0, 1), cA + hstepA, voffA);
    if (wr == 1) PG8_BAR;
    PG8_WAIT_V(2); PG8_BAR;
    PG8_STAGE(PG8_SB(1, 0), cB + kstep, voffB); PG8_STAGE(PG8_SA(1, 0), PG8_AK(cA, 1), voffA); PG8_STAGE(PG8_SB(1, 1), cB + hstep + kstep, voffB);
    PG8_WAIT_V(6); PG8_BAR;
    for (;;) {
        const bool has_next = S.next(ui + 1, nxt);
        const char* nA = has_next ? (const char*)g.A + g.aoffs(nxt.pm) : cA; const char* nB = has_next ? (const char*)g.Bt + (size_t)nxt.pn * tstep : cB;
        for (int t = 0; t < nt; t += 2) {
            const bool last = (t == nt - 2);
            const char* a1 = PG8_AK(cA, t + 1);
            const char* a2 = last ? nA : PG8_AK(cA, t + 2); const char* b2 = last ? nB : cB + (size_t)(t + 2) * kstep;
            const char* a3 = last ? PG8_AK(nA, 1) : PG8_AK(cA, t + 3); const char* b3 = b2 + kstep;
            PG8_LDB(B0, 0, 0); PG8_LDB(B1, 0, 1); PG8_SCHED; PG8_LDA(At, 0, 0); PG8_STAGE(PG8_SA(1, 1), a1 + hstepA, voffA);
            PG8_WAIT_V(8); PG8_WAIT_L(0); PG8_BAR; PG8_MMA(0, 0, At, B0); PG8_MMA(0, 1, At, B1); PG8_BAR; PG8_SCHED;
            PG8_LDA(At, 0, 1); PG8_STAGE(PG8_SB(0, 0), b2, voffB); PG8_STAGE(PG8_SB(0, 1), b2 + hstep, voffB); PG8_STAGE(PG8_SA(0, 0), a2, voffA);
            PG8_WAIT_V(8); PG8_WAIT_L(0); PG8_BAR; PG8_MMA(1, 0, At, B0); PG8_MMA(1, 1, At, B1); PG8_BAR; PG8_SCHED;
            PG8_LDB(B0, 1, 0); PG8_LDB(B1, 1, 1); PG8_SCHED; PG8_LDA(At, 1, 0); PG8_STAGE(PG8_SA(0, 1), a2 + hstepA, voffA);
            PG8_WAIT_V(8); PG8_WAIT_L(0); PG8_BAR; PG8_MMA(0, 0, At, B0); PG8_MMA(0, 1, At, B1); PG8_BAR; PG8_SCHED;
            PG8_LDA(At, 1, 1); PG8_STAGE(PG8_SB(1, 0), b3, voffB); PG8_STAGE(PG8_SB(1, 1), b3 + hstep, voffB); PG8_STAGE(PG8_SA(1, 0), a3, voffA);
            PG8_WAIT_V(8); PG8_WAIT_L(0); PG8_BAR; PG8_MMA(1, 0, At, B0); PG8_MMA(1, 1, At, B1); PG8_BAR; PG8_SCHED;
            if constexpr (Epi::MIDK) { if (t + 2 == split) { PG8_WAIT_V(0); E.mid(acc, cur, wr, wc, fr, fq); PG8_WAIT_V(0); PG8_SCHED; } }
        }
        if constexpr (ALIGN_EPI) { if (wr == 0) PG8_BAR; }
        E(acc, cur, wr, wc, fr, fq);
        if (!has_next) break;
#pragma unroll
        for (int a = 0; a < 2; ++a)
#pragma unroll
            for (int b = 0; b < 2; ++b)
#pragma unroll
                for (int m = 0; m < 4; ++m)
#pragma unroll
                    for (int n = 0; n < 2; ++n) acc[a][b][m][n] = (f32x4){0.f, 0.f, 0.f, 0.f};
        cur = nxt; cA = nA; cB = nB; ++ui;
        if constexpr (ALIGN_EPI) { if (wr == 1) PG8_BAR; }
    }
    PG8_WAIT_V(0);
    if constexpr (!ALIGN_EPI) { if (wr == 0) PG8_BAR; }
    PG8_BAR;
#undef PG8_AK
#undef PG8_SA
#undef PG8_SB
#undef PG8_STAGE
#undef PG8_LDA
#undef PG8_LDB
#undef PG8_MMA
#undef PG8_WAIT_V
#undef PG8_WAIT_L
#undef PG8_BAR
#undef PG8_SCHED
}
}

typedef const f32x4 (&AccRef)[2][2][4][2];
__device__ __forceinline__ u32x4 pack8(const f32x4 a, const f32x4 b) { u32x4 w; w.x = cvt_pk_bf16(a[0], a[1]); w.y = cvt_pk_bf16(a[2], a[3]); w.z = cvt_pk_bf16(b[0], b[1]); w.w = cvt_pk_bf16(b[2], b[3]); return w; }
__device__ __forceinline__ void unpack8(const u32x4 w, float (&o)[8]) { o[0] = bf_lo(w.x); o[1] = bf_hi(w.x); o[2] = bf_lo(w.y); o[3] = bf_hi(w.y); o[4] = bf_lo(w.z); o[5] = bf_hi(w.z); o[6] = bf_lo(w.w); o[7] = bf_hi(w.w); }
__device__ __forceinline__ int real2pad(int R) { return (R >> 11) * LP + 64 + (R & 2047); }

struct EpiP1 {
    static constexpr bool MIDK = false;
    bf16_t *QA, *KA, *VA, *QB, *KVB, *HALO;
    __device__ __forceinline__ void operator()(AccRef acc, const pg8::Unit& u, int wr, int wc, int fr, int fq) const {
        const int seg = u.pn >> 2; bf16_t* base; int ld, c0;
        if (seg < 4) { base = seg == 0 ? QA : (seg == 1 ? KA : (seg == 2 ? VA : QB)); ld = 1024; c0 = (u.pn & 3) * 256; } else { base = KVB; ld = 512; c0 = (u.pn - 16) * 256; }
        const int col0 = c0 + wc * 32 + 8 * fq;
#pragma unroll
        for (int ai = 0; ai < 2; ++ai)
#pragma unroll
            for (int m = 0; m < 4; ++m) { const int row = u.pm * 256 + ai * 128 + wr * 64 + m * 16 + fr;
#pragma unroll
                for (int bj = 0; bj < 2; ++bj) { const u32x4 w = pack8(acc[ai][bj][m][0], acc[ai][bj][m][1]);
                    *(u32x4*)(base + (size_t)row * ld + col0 + bj * 128) = w;
                    if (m == 3) { if (seg < 3 && fr >= 13) *(u32x4*)(HALO + ((size_t)(row >> 6) * 3 + (fr - 13)) * 3072 + seg * 1024 + col0 + bj * 128) = w; } } }
    }
};
struct EpiP3 {
    static constexpr bool MIDK = false;
    bf16_t *YA, *YB, *GA, *GB; const float *SSQ, *normw, *bgate;
    __device__ __forceinline__ void operator()(AccRef acc, const pg8::Unit& u, int wr, int wc, int fr, int fq) const {
        const int seg = u.pn >> 2, c0 = (u.pn & 3) * 256, col0 = c0 + wc * 32 + 8 * fq;
        if (seg >= 2) {
            bf16_t* G = seg == 2 ? GA : GB; const float* bg = bgate + (seg - 2) * 1024;
            f32x4 bv[2][2];
#pragma unroll
            for (int bj = 0; bj < 2; ++bj) { bv[bj][0] = *(const f32x4*)(bg + col0 + bj * 128); bv[bj][1] = *(const f32x4*)(bg + col0 + bj * 128 + 4); }
#pragma unroll
            for (int ai = 0; ai < 2; ++ai)
#pragma unroll
                for (int m = 0; m < 4; ++m) { const int R = u.pm * 256 + ai * 128 + wr * 64 + m * 16 + fr;
#pragma unroll
                    for (int bj = 0; bj < 2; ++bj) { f32x4 v0 = acc[ai][bj][m][0] + bv[bj][0], v1 = acc[ai][bj][m][1] + bv[bj][1];
#pragma unroll
                        for (int e = 0; e < 4; ++e) { v0[e] = sigmoidf_(v0[e]); v1[e] = sigmoidf_(v1[e]); }
                        *(u32x4*)(G + (size_t)R * 1024 + col0 + bj * 128) = pack8(v0, v1); } }
        } else {
            bf16_t* Y = seg == 0 ? YA : YB;
            float nw[8];
#pragma unroll
            for (int e = 0; e < 8; ++e) nw[e] = seg == 0 ? normw[wc * 32 + 8 * fq + e] : 1.f;
#pragma unroll
            for (int ai = 0; ai < 2; ++ai)
#pragma unroll
                for (int m = 0; m < 4; ++m) { const int R = u.pm * 256 + ai * 128 + wr * 64 + m * 16 + fr; const int prow = real2pad(R);
#pragma unroll
                    for (int bj = 0; bj < 2; ++bj) {
                        float rs = 1.f;
                        if (seg == 0) { const int head = (u.pn & 3) * 2 + bj; const f32x4* sp = (const f32x4*)(SSQ + ((size_t)prow * 8 + head) * 8); const f32x4 s0 = sp[0], s1 = sp[1];
                            const float ss = (s0[0] + s0[1]) + (s0[2] + s0[3]) + (s1[0] + s1[1]) + (s1[2] + s1[3]); rs = rsqrtf(ss * (1.f / 128.f) + 1e-6f); }
                        bf16_t* p = Y + (size_t)prow * 1024 + col0 + bj * 128; const u32x4 ow = *(const u32x4*)p; float o[8]; unpack8(ow, o);
                        f32x4 v0, v1;
#pragma unroll
                        for (int e = 0; e < 4; ++e) { v0[e] = o[e] * rs * nw[e] * siluf_(acc[ai][bj][m][0][e]); v1[e] = o[4 + e] * rs * nw[4 + e] * siluf_(acc[ai][bj][m][1][e]); }
                        *(u32x4*)p = pack8(v0, v1); } }
        }
    }
};
struct EpiP4 {
    static constexpr bool MIDK = true;
    const bf16_t *GA, *GB; bf16_t* MIX;
    __device__ __forceinline__ void mid(f32x4 (&acc)[2][2][4][2], const pg8::Unit& u, int wr, int wc, int fr_, int fq) const {
        int fr = fr_; asm volatile("" : "+v"(fr));
        const int col0 = u.pn * 256 + wc * 32 + 8 * fq;
#pragma unroll
        for (int ai = 0; ai < 2; ++ai)
#pragma unroll
            for (int m = 0; m < 4; ++m) { const size_t R = u.pm * 256 + ai * 128 + wr * 64 + m * 16 + fr;
#pragma unroll
                for (int bj = 0; bj < 2; ++bj) { const size_t off = R * 1024 + col0 + bj * 128; float ga[8], gb[8]; unpack8(*(const u32x4*)(GA + off), ga); unpack8(*(const u32x4*)(GB + off), gb);
#pragma unroll
                    for (int e = 0; e < 4; ++e) { acc[ai][bj][m][0][e] *= ga[e] * __builtin_amdgcn_rcpf(gb[e]); acc[ai][bj][m][1][e] *= ga[4 + e] * __builtin_amdgcn_rcpf(gb[4 + e]); } }
                asm volatile("" ::: "memory"); }
    }
    __device__ __forceinline__ void operator()(AccRef acc, const pg8::Unit& u, int wr, int wc, int fr, int fq) const {
        const int col0 = u.pn * 256 + wc * 32 + 8 * fq;
#pragma unroll
        for (int ai = 0; ai < 2; ++ai)
#pragma unroll
            for (int m = 0; m < 4; ++m) { const size_t R = u.pm * 256 + ai * 128 + wr * 64 + m * 16 + fr;
#pragma unroll
                for (int bj = 0; bj < 2; ++bj) { const size_t off = R * 1024 + col0 + bj * 128; float g[8]; unpack8(*(const u32x4*)(GB + off), g);
                    f32x4 v0, v1;
#pragma unroll
                    for (int e = 0; e < 4; ++e) { v0[e] = g[e] * acc[ai][bj][m][0][e]; v1[e] = g[4 + e] * acc[ai][bj][m][1][e]; }
                    *(u32x4*)(MIX + off) = pack8(v0, v1); } }
    }
};
struct EpiP5 {
    static constexpr bool MIDK = false;
    const float* X; float* OUT;
    __device__ __forceinline__ void operator()(AccRef acc, const pg8::Unit& u, int wr, int wc, int fr, int fq) const {
        const int col0 = u.pn * 256 + wc * 32 + 8 * fq;
#pragma unroll
        for (int ai = 0; ai < 2; ++ai)
#pragma unroll
            for (int m = 0; m < 4; ++m) { const size_t R = u.pm * 256 + ai * 128 + wr * 64 + m * 16 + fr;
#pragma unroll
                for (int bj = 0; bj < 2; ++bj) { const size_t off = R * 1024 + col0 + bj * 128;
                    const f32x4 x0 = *(const f32x4*)(X + off), x1 = *(const f32x4*)(X + off + 4);
                    *(f32x4*)(OUT + off) = x0 * DN_ALPHA + acc[ai][bj][m][0]; *(f32x4*)(OUT + off + 4) = x1 * DN_ALPHA + acc[ai][bj][m][1]; } }
    }
};

struct Args {
    const float *x, *meta, *w_in, *b_gate, *conv_w, *a_log, *dt_bias, *gdn_norm_w, *sinks, *w_proj_a, *w_proj_b, *w_out, *ln_w, *ln_b;
    float* out; unsigned char* ws;
};

__device__ __forceinline__ void transpose_item(const float* W, int ldw, int col0, bf16_t* WT, int row0, LAS float* scr, int item, int nblk, int lane, int ldt = 1024, int kc0 = 0) {
    const int kb = item / nblk, nb = item % nblk, k0 = 64 * kb, n0 = 32 * nb;
#pragma unroll 8
    for (int i = 0; i < 32; ++i) { const int kk = 2 * i + (lane >> 5); scr[kk * 33 + (lane & 31)] = W[(size_t)(k0 + kk) * ldw + col0 + n0 + (lane & 31)]; }
    LDS_WAIT(); asm volatile("" ::: "memory");
    const int c = lane & 7;
#pragma unroll
    for (int j = 0; j < 4; ++j) { const int n = (lane >> 3) + 8 * j; const LAS float* s = scr + (8 * c) * 33 + n;
        u32x4 o; o.x = cvt_pk_bf16(s[0 * 33], s[1 * 33]); o.y = cvt_pk_bf16(s[2 * 33], s[3 * 33]); o.z = cvt_pk_bf16(s[4 * 33], s[5 * 33]); o.w = cvt_pk_bf16(s[6 * 33], s[7 * 33]);
        *(u32x4*)(WT + (size_t)(row0 + n0 + n) * ldt + kc0 + k0 + 8 * c) = o; }
    LDS_WAIT(); asm volatile("" ::: "memory");
}

__device__ __forceinline__ void phase0(const Args& a, LAS unsigned char* lds, int bid, int G) {
    const int tid = threadIdx.x, lane = tid & 63, wave = tid >> 6;
    const int gw = bid * 8 + wave, NGW = G * 8;
    bf16_t* WT1 = (bf16_t*)(a.ws + WS_WT1); bf16_t* WT2 = (bf16_t*)(a.ws + WS_WT2);
    bf16_t* WA = (bf16_t*)(a.ws + WS_WA); bf16_t* WB = (bf16_t*)(a.ws + WS_WB); bf16_t* WO = (bf16_t*)(a.ws + WS_WO);
    LAS float* scr = (LAS float*)(lds + wave * 8704);
    constexpr int I0 = 16 * 96, I1 = 16 * 48, I2 = 16 * 32, I3 = 16 * 96, I4 = 16 * 32;
    constexpr int NIT = I0 + I1 + I2 + I3 + 3 * I4;
    for (int it = gw; it < NIT; it += NGW) {
        int r = it;
        if (r < I0) { transpose_item(a.w_in, NWIN, 0, WT1, 0, scr, r, 96, lane); continue; } r -= I0;
        if (r < I1) { transpose_item(a.w_in, NWIN, 4112, WT1, 3072, scr, r, 48, lane); continue; } r -= I1;
        if (r < I2) { transpose_item(a.w_in, NWIN, 3072, WT2, 0, scr, r, 32, lane); continue; } r -= I2;
        if (r < I3) { transpose_item(a.w_in, NWIN, 5648, WT2, 1024, scr, r, 96, lane); continue; } r -= I3;
        if (r < I4) { transpose_item(a.w_proj_a, 1024, 0, WA, 0, scr, r, 32, lane, 2048, 0); continue; } r -= I4;
        if (r < I4) { transpose_item(a.w_proj_b, 1024, 0, WA, 0, scr, r, 32, lane, 2048, 1024); continue; } r -= I4;
        transpose_item(a.w_out, 1024, 0, WO, 0, scr, r, 32, lane);
    }
    __syncthreads();
    LAS float* wl = (LAS float*)lds;
    for (int i = tid; i < 1024 * 16; i += 512) { const int k = i >> 4, c = i & 15; const int slot = ((k >> 8) * 4 + (k & 3)) * 64 + ((k & 255) >> 2);
        wl[slot * 20 + c] = a.w_in[(size_t)k * NWIN + 4096 + c]; }
    __syncthreads();
    bf16_t* HB = (bf16_t*)a.out; float* BD = (float*)(a.ws + WS_BD);
    for (int row = gw; row < MP; row += NGW) {
        const int b = row / LP, tp = row - b * LP;
        u32x2* hb8 = (u32x2*)(HB + (size_t)row * 1024);
        if (tp < 48) {
#pragma unroll
            for (int j = 0; j < 4; ++j) hb8[lane + 64 * j] = (u32x2){0u, 0u};
            if (lane < 16) BD[(size_t)row * 16 + lane] = 0.f;
            continue;
        }
        const float* src = tp < 64 ? a.meta + (size_t)(tp - 48) * 1024 : a.x + ((size_t)b * SEQ + (tp - 64)) * 1024;
        f32x4 v[4];
#pragma unroll
        for (int j = 0; j < 4; ++j) v[j] = ((const f32x4*)src)[lane + 64 * j];
#pragma unroll
        for (int j = 0; j < 4; ++j) hb8[lane + 64 * j] = (u32x2){cvt_pk_bf16(v[j][0], v[j][1]), cvt_pk_bf16(v[j][2], v[j][3])};
        float acc[16];
#pragma unroll
        for (int c = 0; c < 16; ++c) acc[c] = 0.f;
#pragma unroll
        for (int j = 0; j < 4; ++j)
#pragma unroll
            for (int e = 0; e < 4; ++e) { const LAS f32x4* wp = (const LAS f32x4*)(wl + ((j * 4 + e) * 64 + lane) * 20); const float hv = v[j][e];
#pragma unroll
                for (int c4 = 0; c4 < 4; ++c4) { const f32x4 w4 = wp[c4];
#pragma unroll
                    for (int q = 0; q < 4; ++q) acc[4 * c4 + q] += hv * w4[q]; } }
        float t8[8], t4[4], t2[2], t1;
        { const bool hi = lane & 32;
#pragma unroll
          for (int i = 0; i < 8; ++i) { const float send = hi ? acc[i] : acc[8 + i], keep = hi ? acc[8 + i] : acc[i]; t8[i] = keep + __shfl_xor(send, 32); } }
        { const bool hi = lane & 16;
#pragma unroll
          for (int i = 0; i < 4; ++i) { const float send = hi ? t8[i] : t8[4 + i], keep = hi ? t8[4 + i] : t8[i]; t4[i] = keep + __shfl_xor(send, 16); } }
        { const bool hi = lane & 8;
#pragma unroll
          for (int i = 0; i < 2; ++i) { const float send = hi ? t4[i] : t4[2 + i], keep = hi ? t4[2 + i] : t4[i]; t2[i] = keep + __shfl_xor(send, 8); } }
        { const bool hi = lane & 4; const float send = hi ? t2[0] : t2[1], keep = hi ? t2[1] : t2[0]; t1 = keep + __shfl_xor(send, 4); }
        t1 += __shfl_xor(t1, 2); t1 += __shfl_xor(t1, 1);
        const int idx = ((lane >> 5) & 1) * 8 + ((lane >> 4) & 1) * 4 + ((lane >> 3) & 1) * 2 + ((lane >> 2) & 1);
        if ((lane & 3) == 0) BD[(size_t)row * 16 + idx] = t1;
    }
}

constexpr int P2_QS = 0, P2_KS = 17408, P2_VS = 34816, P2_KF = 68608, P2_AM = 102400, P2_XO = 119808, P2_GC = 137216, P2_BETA = 137472, P2_EGC = 137728, P2_SCL = 137984;
__device__ __forceinline__ void phase2a(const Args& a, LAS unsigned char* lds, int bid, int G) {
    bf16_t* QA = (bf16_t*)(a.ws + WS_QA); bf16_t* KA = (bf16_t*)(a.ws + WS_KA); bf16_t* VA = (bf16_t*)(a.ws + WS_VA);
    bf16_t* WBUF = (bf16_t*)(a.ws + WS_WBUF); bf16_t* ATT = (bf16_t*)(a.ws + WS_ATT); const bf16_t* HALO = (const bf16_t*)(a.ws + WS_HALO);
    const float* BD = (const float*)(a.ws + WS_BD); float* GL = (float*)(a.ws + WS_GL);
    unsigned praw[3][11]; f32x2 pcw[3][4]; float pbd[2];
#define P2_FETCH(it_) do { const int tl_ = threadIdx.x, ln_ = tl_ & 63, wv_ = tl_ >> 6; const int bh_ = (it_) / NCH, n_ = (it_) - bh_ * NCH, b_ = bh_ >> 3, h_ = bh_ & 7; \
        const int rb_ = b_ * LP + 64 * n_, gc_ = b_ * NCH + n_, col_ = h_ * 128 + 2 * ln_, r0_ = wv_ * 8; \
        _Pragma("unroll") for (int seg = 0; seg < 3; ++seg) { const bf16_t* src_ = seg == 0 ? QA : (seg == 1 ? KA : VA); \
            _Pragma("unroll") for (int t = 0; t < 11; ++t) { const int ri = r0_ - 3 + t; unsigned w_; \
                if (ri >= 0) w_ = *(const unsigned*)(src_ + (size_t)(rb_ + ri) * 1024 + col_); \
                else w_ = n_ > 0 ? *(const unsigned*)(HALO + ((size_t)(gc_ - 1) * 3 + t) * 3072 + seg * 1024 + col_) : 0u; \
                praw[seg][t] = w_; } \
            _Pragma("unroll") for (int j = 0; j < 4; ++j) pcw[seg][j] = *(const f32x2*)(a.conv_w + (size_t)j * 3072 + seg * 1024 + col_); } \
        pbd[0] = BD[(size_t)(rb_ + ln_) * 16 + h_]; pbd[1] = BD[(size_t)(rb_ + ln_) * 16 + 8 + h_]; } while (0)
    if (bid < 64 * NCH) P2_FETCH(bid);
    for (int item = bid; item < 64 * NCH; item += G) {
        int tid_ = threadIdx.x; asm volatile("" : "+v"(tid_));
        const int tid = tid_, lane = tid & 63, wave = tid >> 6, fr = lane & 15, fq = lane >> 4;
        int z; asm volatile("s_mov_b32 %0, 0" : "=s"(z));
        LAS unsigned char* ldz = lds + z;
        LAS bf16_t* Qs = (LAS bf16_t*)(ldz + P2_QS); LAS bf16_t* Ks = (LAS bf16_t*)(ldz + P2_KS); LAS float* Vs = (LAS float*)(ldz + P2_VS);
        LAS float* Am = (LAS float*)(ldz + P2_AM); LAS bf16_t* Xo = (LAS bf16_t*)(ldz + P2_XO);
        LAS float* GC = (LAS float*)(ldz + P2_GC); LAS float* BETA = (LAS float*)(ldz + P2_BETA); LAS float* EGC = (LAS float*)(ldz + P2_EGC);
        LAS float* RX = (LAS float*)(ldz + P2_VS); LAS float* SCL = (LAS float*)(ldz + P2_SCL); LAS float* UPD = (LAS float*)(ldz + P2_QS);
        const int bh = item / NCH, n = item - bh * NCH, b = bh >> 3, h = bh & 7;
        const int rowbase = b * LP + 64 * n, gchunk = b * NCH + n;
        {
            const int r0 = wave * 8;
#pragma unroll
            for (int seg = 0; seg < 3; ++seg) {
                float x0[11], x1[11];
#pragma unroll
                for (int t = 0; t < 11; ++t) { x0[t] = bf_lo(praw[seg][t]); x1[t] = bf_hi(praw[seg][t]); }
#pragma unroll
                for (int rr = 0; rr < 8; ++rr) {
                    float y0 = 0.f, y1 = 0.f;
#pragma unroll
                    for (int j = 0; j < 4; ++j) { y0 += pcw[seg][j][0] * x0[rr + j]; y1 += pcw[seg][j][1] * x1[rr + j]; }
                    y0 = siluf_(y0); y1 = siluf_(y1);
                    const int r = r0 + rr;
                    if (seg < 2) {
                        const float ss = wave_sum_dpp(y0 * y0 + y1 * y1);
                        const float sc = rsqrtf(ss + 1e-6f) * (seg == 0 ? 0.08838834764831845f : 1.f);
                        *(LAS unsigned*)((seg == 0 ? Qs : Ks) + r * 136 + 2 * lane) = cvt_pk_bf16(y0 * sc, y1 * sc);
                        if (seg == 1) *(LAS f32x2*)(RX + r * 264 + 128 + 2 * lane) = (f32x2){y0 * sc, y1 * sc};
                    } else { *(LAS f32x2*)(RX + r * 264 + 2 * lane) = (f32x2){y0, y1}; }
                }
            }
            if (wave == 7) {
                const float braw = pbd[0], araw = pbd[1];
                const float xx = araw + a.dt_bias[h];
                const float sp = xx > 20.f ? xx : log1pf(__expf(xx));
                float g = -__expf(a.a_log[h]) * sp;
                if (n == 0 && lane < 48) g = 0.f;
#pragma unroll
                for (int o = 1; o < 64; o <<= 1) { const float t = __shfl_up(g, o); if (lane >= o) g += t; }
                const float be = sigmoidf_(braw), eg = __expf(g);
                GC[lane] = g; BETA[lane] = be; EGC[lane] = eg; SCL[lane] = be; SCL[64 + lane] = be * eg;
            }
            { const int nit = item + G < 64 * NCH ? item + G : item; P2_FETCH(nit); }
        }
        __syncthreads();
        {
            const int mi = wave >> 1;
            bf16x8 kA[4], qA[4];
#pragma unroll
            for (int kk = 0; kk < 4; ++kk) { kA[kk] = *(const LAS bf16x8*)(Ks + (16 * mi + fr) * 136 + 32 * kk + 8 * fq); qA[kk] = *(const LAS bf16x8*)(Qs + (16 * mi + fr) * 136 + 32 * kk + 8 * fq); }
            const int i = 16 * mi + fr; const float gci = GC[i], bi = BETA[i];
#pragma unroll
            for (int jj = 0; jj < 2; ++jj) {
                const int nj = (wave & 1) * 2 + jj;
                bf16_t* ap = ATT + (size_t)item * 4096 + i * 64 + 16 * nj + 4 * fq;
                if (nj > mi) { *(u32x2*)ap = (u32x2){0u, 0u}; continue; }
                f32x4 ck = {0.f, 0.f, 0.f, 0.f}, cq = {0.f, 0.f, 0.f, 0.f};
#pragma unroll
                for (int kk = 0; kk < 4; ++kk) { const bf16x8 kB = *(const LAS bf16x8*)(Ks + (16 * nj + fr) * 136 + 32 * kk + 8 * fq);
                    ck = __builtin_amdgcn_mfma_f32_16x16x32_bf16(kB, kA[kk], ck, 0, 0, 0); cq = __builtin_amdgcn_mfma_f32_16x16x32_bf16(kB, qA[kk], cq, 0, 0, 0); }
                f32x4 am, at;
#pragma unroll
                for (int r = 0; r < 4; ++r) { const int j = 16 * nj + 4 * fq + r; const float d = j <= i ? __expf(gci - GC[j]) : 0.f;
                    am[r] = j < i ? bi * ck[r] * d : 0.f; at[r] = cq[r] * d; }
                *(LAS f32x4*)(Am + i * 68 + 16 * nj + 4 * fq) = am;
                *(u32x2*)ap = (u32x2){cvt_pk_bf16(at[0], at[1]), cvt_pk_bf16(at[2], at[3])};
            }
        }
        __syncthreads();
        {
            const int c = tid & 255; const bool solver = tid < 256;
            unsigned amv; asm volatile("v_mov_b32 %0, %1" : "=v"(amv) : "s"((unsigned)(size_t)Am));
            const LAS float* AmV = (const LAS float*)(size_t)amv;
            const LAS float* rscl = SCL + (c < 128 ? 0 : 64);
            LAS float* RXc = RX + c;
#pragma unroll
            for (int bi = 0; bi < 4; ++bi) {
                if (bi > 0) {
#pragma unroll
                    for (int t2 = 0; t2 < 2; ++t2) { const int ct = 2 * wave + t2; f32x4 acc = {0.f, 0.f, 0.f, 0.f};
#pragma unroll
                        for (int ks = 0; ks < 4 * bi; ++ks) acc = __builtin_amdgcn_mfma_f32_16x16x4f32(Am[(16 * bi + fr) * 68 + 4 * ks + fq], RX[(4 * ks + fq) * 264 + 16 * ct + fr], acc, 0, 0, 0);
#pragma unroll
                        for (int r = 0; r < 4; ++r) UPD[(4 * fq + r) * 260 + 16 * ct + fr] = acc[r]; }
                    __syncthreads();
                }
                if (solver) {
                    float xb[16];
#pragma unroll
                    for (int r = 0; r < 16; ++r) { xb[r] = rscl[16 * bi + r] * RXc[(16 * bi + r) * 264]; if (bi > 0) xb[r] -= UPD[r * 260 + c]; }
#pragma unroll
                    for (int j = 0; j < 15; ++j) {
#pragma unroll
                        for (int r = j + 1; r < 16; ++r) xb[r] -= AmV[(16 * bi + r) * 68 + 16 * bi + j] * xb[j];
                        if ((j & 3) == 3) asm volatile("" ::: "memory");
                    }
#pragma unroll
                    for (int r = 0; r < 16; ++r) RXc[(16 * bi + r) * 264] = xb[r];
                } else if (bi == 0) {
                    const int t = tid - 256;
#pragma unroll
                    for (int e4 = 0; e4 < 4; ++e4) { const int id = t + 256 * e4, i = id >> 4, cc = id & 15; float q[8]; unpack8(*(const LAS u32x4*)(Qs + i * 136 + 8 * cc), q); const float eg = EGC[i];
                        u32x4 w; w.x = cvt_pk_bf16(q[0] * eg, q[1] * eg); w.y = cvt_pk_bf16(q[2] * eg, q[3] * eg); w.z = cvt_pk_bf16(q[4] * eg, q[5] * eg); w.w = cvt_pk_bf16(q[6] * eg, q[7] * eg);
                        *(u32x4*)(QA + (size_t)(rowbase + i) * 1024 + h * 128 + 8 * cc) = w; }
                    const float gl = GC[63];
#pragma unroll
                    for (int e4 = 0; e4 < 4; ++e4) { const int id = t + 256 * e4, dk = id >> 3, ib = id & 7; float kv[8];
#pragma unroll
                        for (int e = 0; e < 8; ++e) { const int i = 8 * ib + e; kv[e] = bf2f(Ks[i * 136 + dk]) * __expf(gl - GC[i]); }
                        u32x4 w; w.x = cvt_pk_bf16(kv[0], kv[1]); w.y = cvt_pk_bf16(kv[2], kv[3]); w.z = cvt_pk_bf16(kv[4], kv[5]); w.w = cvt_pk_bf16(kv[6], kv[7]);
                        *(u32x4*)(KA + (size_t)(rowbase + (dk >> 1)) * 1024 + h * 128 + (dk & 1) * 64 + 8 * ib) = w; }
                    if (t == 0) GL[item] = __expf(gl);
                }
                if (bi < 3) __syncthreads();
            }
            if (solver) {
                if (c < 128) {
                    const int s32 = c & ~31, dvl = c & 31;
#pragma unroll
                    for (int q = 0; q < 8; ++q) { float x8[8];
#pragma unroll
                        for (int e = 0; e < 8; ++e) x8[e] = RXc[(8 * q + e) * 264];
                        u32x4 w; w.x = cvt_pk_bf16(x8[0], x8[1]); w.y = cvt_pk_bf16(x8[2], x8[3]); w.z = cvt_pk_bf16(x8[4], x8[5]); w.w = cvt_pk_bf16(x8[6], x8[7]);
                        *(u32x4*)(VA + (size_t)(rowbase + 2 * dvl + (q >> 2)) * 1024 + h * 128 + s32 + (q & 3) * 8) = w; }
                } else {
                    const int dk = c - 128;
#pragma unroll
                    for (int i = 0; i < 64; i += 2) { const unsigned w = cvt_pk_bf16(RXc[i * 264], RXc[(i + 1) * 264]); Xo[i * 136 + dk] = (bf16_t)(w & 0xffffu); Xo[(i + 1) * 136 + dk] = (bf16_t)(w >> 16); }
                }
            }
        }
        __syncthreads();
#pragma unroll
        for (int e2 = 0; e2 < 2; ++e2) { const int id = tid + 512 * e2, i = id >> 4, cc = id & 15;
            *(u32x4*)(WBUF + (size_t)(rowbase + i) * 1024 + h * 128 + 8 * cc) = *(const LAS u32x4*)(Xo + i * 136 + 8 * cc); }
        __syncthreads();
    }
#undef P2_FETCH
}

constexpr int SC_ST = 0, SC_VT = 8704, SC_W = 13312, SC_Q = 30720, SC_K = 48128, SC_A = 66560, SC_U = 75776;
__device__ __forceinline__ void scan_item(const Args& a, LAS unsigned char* lds, int sid) {
    int tid_ = threadIdx.x; asm volatile("" : "+v"(tid_));
    const int tid = tid_, lane = tid & 63, wave = tid >> 6, fr = lane & 15, fq = lane >> 4;
    const int bh = (sid & 7) * 8 + (sid >> 5), s = (sid >> 3) & 3, b = bh >> 3, h = bh & 7;
    const bf16_t* QA = (const bf16_t*)(a.ws + WS_QA); const bf16_t* KA = (const bf16_t*)(a.ws + WS_KA); bf16_t* VA = (bf16_t*)(a.ws + WS_VA);
    const bf16_t* WBUF = (const bf16_t*)(a.ws + WS_WBUF); const bf16_t* ATT = (const bf16_t*)(a.ws + WS_ATT);
    const float* GL = (const float*)(a.ws + WS_GL); float* SSQ = (float*)(a.ws + WS_SSQ);
    LAS bf16_t* ST = (LAS bf16_t*)(lds + SC_ST);
    LAS bf16_t* VT = (LAS bf16_t*)(lds + SC_VT);
    const int mt = wave >> 1, nt = wave & 1, colh = h * 128;
    const int dvl = 16 * nt + fr, i0 = 16 * mt + 4 * fq;
    const int srow = tid >> 4, scc = tid & 15;
    const unsigned dW0 = SC_W + srow * 272 + scc * 16, dW1 = dW0 + 32 * 272, dQ0 = dW0 + (SC_Q - SC_W), dQ1 = dQ0 + 32 * 272;
    const unsigned dK0 = SC_K + (2 * srow + (scc >> 3)) * 144 + (scc & 7) * 16, dK1 = dK0 + 64 * 144;
    const unsigned dA = SC_A + (tid >> 3) * 144 + (tid & 7) * 16;
    const int urow = (tid & 255) >> 2, uc4 = tid & 3;
    const unsigned dU = SC_U + (urow >> 1) * 144 + (32 * (urow & 1) + 8 * uc4) * 2;
    u32x4 Ra[8], Rb[8];
#define SC_LOAD(R, n_) do { const int rb_ = b * LP + 64 * (n_); const size_t o0_ = (size_t)(rb_ + srow) * 1024 + colh + 8 * scc, o1_ = o0_ + 32 * 1024; \
        R[0] = *(const u32x4*)(WBUF + o0_); R[1] = *(const u32x4*)(WBUF + o1_); R[2] = *(const u32x4*)(QA + o0_); R[3] = *(const u32x4*)(QA + o1_); \
        R[4] = *(const u32x4*)(KA + o0_); R[5] = *(const u32x4*)(KA + o1_); R[6] = *(const u32x4*)(ATT + (size_t)(bh * NCH + (n_)) * 4096 + 8 * tid); \
        R[7] = *(const u32x4*)(VA + (size_t)(rb_ + urow) * 1024 + colh + 32 * s + 8 * uc4); } while (0)
#define SC_PARK(R) do { *(LAS u32x4*)(lds + dW0) = R[0]; *(LAS u32x4*)(lds + dW1) = R[1]; *(LAS u32x4*)(lds + dQ0) = R[2]; *(LAS u32x4*)(lds + dQ1) = R[3]; \
        *(LAS u32x4*)(lds + dK0) = R[4]; *(LAS u32x4*)(lds + dK1) = R[5]; *(LAS u32x4*)(lds + dA) = R[6]; if (tid < 256) *(LAS u32x4*)(lds + dU) = R[7]; } while (0)
    bf16x8 wA[4], qA[4], aA[2], kA[2]; u32x2 uw;
#define SC_FRAGS() do { \
        _Pragma("unroll") for (int kk = 0; kk < 4; ++kk) { wA[kk] = *(const LAS bf16x8*)(lds + SC_W + (16 * mt + fr) * 272 + (32 * kk + 8 * fq) * 2); qA[kk] = *(const LAS bf16x8*)(lds + SC_Q + (16 * mt + fr) * 272 + (32 * kk + 8 * fq) * 2); } \
        _Pragma("unroll") for (int kk = 0; kk < 2; ++kk) { aA[kk] = *(const LAS bf16x8*)(lds + SC_A + (16 * mt + fr) * 144 + (32 * kk + 8 * fq) * 2); kA[kk] = *(const LAS bf16x8*)(lds + SC_K + (16 * wave + fr) * 144 + (32 * kk + 8 * fq) * 2); } \
        uw = *(const LAS u32x2*)(lds + SC_U + dvl * 144 + i0 * 2); } while (0)
    for (int i = tid; i < 32 * 136 / 2; i += 512) ((LAS unsigned*)ST)[i] = 0u;
    f32x4 Sacc[2] = {{0.f, 0.f, 0.f, 0.f}, {0.f, 0.f, 0.f, 0.f}};
    SC_LOAD(Ra, 0); SC_PARK(Ra);
    __syncthreads();
    SC_FRAGS();
    const float glv = lane < NCH ? GL[bh * NCH + lane] : 0.f;
    __syncthreads();
    SC_LOAD(Ra, 1); SC_PARK(Ra);
    SC_LOAD(Ra, 2);
    for (int n = 0; n < NCH; ++n) {
        const int rowbase = b * LP + 64 * n;
        { const int nn = n + 3 < NCH ? n + 3 : NCH - 1; SC_LOAD(Rb, nn); }
        const float gl = __builtin_bit_cast(float, __builtin_amdgcn_readlane(__builtin_bit_cast(int, glv), n));
        f32x4 a1 = {0.f, 0.f, 0.f, 0.f}, a2 = {0.f, 0.f, 0.f, 0.f};
#pragma unroll
        for (int kk = 0; kk < 4; ++kk) { const bf16x8 sf = *(const LAS bf16x8*)(ST + (16 * nt + fr) * 136 + 32 * kk + 8 * fq);
            a1 = __builtin_amdgcn_mfma_f32_16x16x32_bf16(wA[kk], sf, a1, 0, 0, 0); a2 = __builtin_amdgcn_mfma_f32_16x16x32_bf16(sf, qA[kk], a2, 0, 0, 0); }
        { const float v0 = bf_lo(uw.x) - a1[0], v1 = bf_hi(uw.x) - a1[1], v2 = bf_lo(uw.y) - a1[2], v3 = bf_hi(uw.y) - a1[3];
          *(LAS u32x2*)(VT + (16 * nt + fr) * 72 + 16 * mt + 4 * fq) = (u32x2){cvt_pk_bf16(v0, v1), cvt_pk_bf16(v2, v3)}; }
        __syncthreads();
#pragma unroll
        for (int kk = 0; kk < 2; ++kk) { const bf16x8 vf = *(const LAS bf16x8*)(VT + (16 * nt + fr) * 72 + 32 * kk + 8 * fq);
            a2 = __builtin_amdgcn_mfma_f32_16x16x32_bf16(vf, aA[kk], a2, 0, 0, 0); }
        { const int row = rowbase + 16 * mt + fr;
          *(u32x2*)(VA + (size_t)row * 1024 + colh + 32 * s + 16 * nt + 4 * fq) = (u32x2){cvt_pk_bf16(a2[0], a2[1]), cvt_pk_bf16(a2[2], a2[3])};
          float p = a2[0] * a2[0] + a2[1] * a2[1] + a2[2] * a2[2] + a2[3] * a2[3]; p += __shfl_xor(p, 16); p += __shfl_xor(p, 32);
          if (fq == 0) SSQ[((size_t)row * 8 + h) * 8 + s * 2 + nt] = p; }
#pragma unroll
        for (int n3 = 0; n3 < 2; ++n3) { Sacc[n3] = Sacc[n3] * gl;
#pragma unroll
            for (int kk = 0; kk < 2; ++kk) { const bf16x8 vf = *(const LAS bf16x8*)(VT + (16 * n3 + fr) * 72 + 32 * kk + 8 * fq);
                Sacc[n3] = __builtin_amdgcn_mfma_f32_16x16x32_bf16(kA[kk], vf, Sacc[n3], 0, 0, 0); }
            *(LAS u32x2*)(ST + (16 * n3 + fr) * 136 + 16 * wave + 4 * fq) = (u32x2){cvt_pk_bf16(Sacc[n3][0], Sacc[n3][1]), cvt_pk_bf16(Sacc[n3][2], Sacc[n3][3])}; }
        SC_FRAGS();
        __syncthreads();
        SC_PARK(Ra);
#pragma unroll
        for (int e = 0; e < 8; ++e) Ra[e] = Rb[e];
    }
    __syncthreads();
#undef SC_LOAD
#undef SC_PARK
#undef SC_FRAGS
}

__device__ __forceinline__ void swa_items(const Args& a, LAS unsigned char* lds, int bid, int G) {
    int tid = threadIdx.x, lane = tid & 63, wave = tid >> 6, fr = lane & 15, fq = lane >> 4;
    bf16_t* QB = (bf16_t*)(a.ws + WS_QB); const bf16_t* KVB = (const bf16_t*)(a.ws + WS_KVB);
    LAS bf16_t* KL = (LAS bf16_t*)lds;
    LAS bf16_t* VTL = (LAS bf16_t*)(lds + 29952);
    u32x4 kreg[4], vreg[4]; bf16x8 qf[2][2];
#define SWA_FETCH(idx_) do { const int b_ = (idx_) >> 7, rem_ = (idx_) & 127, n_ = 1 + (rem_ >> 2), kvh_ = rem_ & 3; \
        _Pragma("unroll") for (int e = 0; e < 4; ++e) { const int id = tid + 512 * e; kreg[e] = (u32x4){0u, 0u, 0u, 0u}; vreg[e] = (u32x4){0u, 0u, 0u, 0u}; \
            if (id < 208 * 8) { const int key = id >> 3, cc = id & 7; int row; bool valid = true; \
                if (key < 16) row = b_ * LP + 48 + key; else { const int jj = (key - 16) >> 6, c = (key - 16) & 63, j = n_ - 2 + jj; valid = j >= 1; row = b_ * LP + 64 * (j < 0 ? 0 : j) + c; } \
                if (valid) { kreg[e] = *(const u32x4*)(KVB + (size_t)row * 512 + kvh_ * 64 + 8 * cc); vreg[e] = *(const u32x4*)(KVB + (size_t)row * 512 + 256 + kvh_ * 64 + 8 * cc); } } } \
        { const int g_ = wave >> 1, half_ = wave & 1, head_ = kvh_ * 4 + g_, rb_ = b_ * LP + 64 * n_; \
          _Pragma("unroll") for (int mt = 0; mt < 2; ++mt) _Pragma("unroll") for (int kk = 0; kk < 2; ++kk) \
              qf[mt][kk] = *(const bf16x8*)(QB + (size_t)(rb_ + 32 * half_ + 16 * mt + fr) * 1024 + head_ * 64 + 32 * kk + 8 * fq); } } while (0)
    if (bid < 1024) SWA_FETCH(bid);
  for (int idx = bid; idx < 1024; idx += G) {
    tid = threadIdx.x; asm volatile("" : "+v"(tid)); lane = tid & 63; wave = tid >> 6; fr = lane & 15; fq = lane >> 4;
    const int b = idx >> 7, rem = idx & 127, n = 1 + (rem >> 2), kvh = rem & 3;
    const int rowbase = b * LP + 64 * n;
#pragma unroll
    for (int e = 0; e < 4; ++e) { const int id = tid + 512 * e;
        if (id < 208 * 8) { const int key = id >> 3, cc = id & 7; const u32x4 kw = kreg[e], vw = vreg[e];
            *(LAS u32x4*)(KL + key * 72 + 8 * cc) = kw;
            LAS bf16_t* vp = VTL + (8 * cc) * 232 + key;
            vp[0 * 232] = (bf16_t)(vw.x & 0xffffu); vp[1 * 232] = (bf16_t)(vw.x >> 16); vp[2 * 232] = (bf16_t)(vw.y & 0xffffu); vp[3 * 232] = (bf16_t)(vw.y >> 16);
            vp[4 * 232] = (bf16_t)(vw.z & 0xffffu); vp[5 * 232] = (bf16_t)(vw.z >> 16); vp[6 * 232] = (bf16_t)(vw.w & 0xffffu); vp[7 * 232] = (bf16_t)(vw.w >> 16); } }
    if (tid < 128) { const int r = tid >> 1, hh = tid & 1; *(LAS u32x4*)(VTL + r * 232 + 208 + 8 * hh) = (u32x4){0u, 0u, 0u, 0u}; }
    __syncthreads();
    {
        const int g = wave >> 1, half = wave & 1, head = kvh * 4 + g;
        const float slope2 = exp2f(-0.5f * (float)(head + 1)) * LOG2E, sink2 = a.sinks[head] * LOG2E;
        f32x4 sc[2][13];
#pragma unroll
        for (int kt = 0; kt < 13; ++kt) {
            const bf16x8 k0 = *(const LAS bf16x8*)(KL + (16 * kt + fr) * 72 + 8 * fq), k1 = *(const LAS bf16x8*)(KL + (16 * kt + fr) * 72 + 32 + 8 * fq);
#pragma unroll
            for (int mt = 0; mt < 2; ++mt) { f32x4 c = {0.f, 0.f, 0.f, 0.f};
                c = __builtin_amdgcn_mfma_f32_16x16x32_bf16(k0, qf[mt][0], c, 0, 0, 0); c = __builtin_amdgcn_mfma_f32_16x16x32_bf16(k1, qf[mt][1], c, 0, 0, 0); sc[mt][kt] = c; }
        }
        float mx[2], sm[2];
#pragma unroll
        for (int mt = 0; mt < 2; ++mt) {
            const int tq = 64 * n + 32 * half + 16 * mt + fr - 48;
            float m = sink2;
#pragma unroll
            for (int kt = 0; kt < 13; ++kt)
#pragma unroll
                for (int r = 0; r < 4; ++r) { const int sidx = 16 * kt + 4 * fq + r; int tk; bool valid = true;
                    if (kt == 0) tk = sidx; else { const int jj = (sidx - 16) >> 6, j = n - 2 + jj; valid = j >= 1; tk = 64 * j + ((sidx - 16) & 63) - 48; }
                    const int dd = tq - tk; const float dist = (float)(dd < 0 ? -dd : dd);
                    const float v = valid ? sc[mt][kt][r] * (0.125f * LOG2E) - slope2 * dist : -1e30f;
                    sc[mt][kt][r] = v; m = fmaxf(m, v); }
            m = fmaxf(m, __shfl_xor(m, 16)); m = fmaxf(m, __shfl_xor(m, 32));
            float ssum = 0.f;
#pragma unroll
            for (int kt = 0; kt < 13; ++kt)
#pragma unroll
                for (int r = 0; r < 4; ++r) { const float p = exp2f(sc[mt][kt][r] - m); sc[mt][kt][r] = p; ssum += p; }
            ssum += __shfl_xor(ssum, 16); ssum += __shfl_xor(ssum, 32);
            mx[mt] = m; sm[mt] = ssum + exp2f(sink2 - m);
        }
        f32x4 oacc[2][4];
#pragma unroll
        for (int mt = 0; mt < 2; ++mt)
#pragma unroll
            for (int nt = 0; nt < 4; ++nt) oacc[mt][nt] = (f32x4){0.f, 0.f, 0.f, 0.f};
#pragma unroll
        for (int kk = 0; kk < 7; ++kk) {
            bf16x8 pf[2];
#pragma unroll
            for (int mt = 0; mt < 2; ++mt) { u32x4 w; w.x = cvt_pk_bf16(sc[mt][2 * kk][0], sc[mt][2 * kk][1]); w.y = cvt_pk_bf16(sc[mt][2 * kk][2], sc[mt][2 * kk][3]);
                if (kk < 6) { w.z = cvt_pk_bf16(sc[mt][2 * kk + 1 < 13 ? 2 * kk + 1 : 12][0], sc[mt][2 * kk + 1 < 13 ? 2 * kk + 1 : 12][1]); w.w = cvt_pk_bf16(sc[mt][2 * kk + 1 < 13 ? 2 * kk + 1 : 12][2], sc[mt][2 * kk + 1 < 13 ? 2 * kk + 1 : 12][3]); }
                else { w.z = 0u; w.w = 0u; }
                pf[mt] = __builtin_bit_cast(bf16x8, w); }
#pragma unroll
            for (int nt = 0; nt < 4; ++nt) {
                const u32x2 v0 = *(const LAS u32x2*)(VTL + (16 * nt + fr) * 232 + 32 * kk + 4 * fq), v1 = *(const LAS u32x2*)(VTL + (16 * nt + fr) * 232 + 32 * kk + 16 + 4 * fq);
                const bf16x8 vf = __builtin_bit_cast(bf16x8, ((u32x4){v0.x, v0.y, v1.x, v1.y}));
#pragma unroll
                for (int mt = 0; mt < 2; ++mt) oacc[mt][nt] = __builtin_amdgcn_mfma_f32_16x16x32_bf16(vf, pf[mt], oacc[mt][nt], 0, 0, 0);
            }
        }
        { const int nidx = idx + G < 1024 ? idx + G : idx; SWA_FETCH(nidx); }
#pragma unroll
        for (int mt = 0; mt < 2; ++mt) { const float inv = 1.f / sm[mt]; (void)mx;
#pragma unroll
            for (int nt = 0; nt < 4; ++nt) { const f32x4 o = oacc[mt][nt] * inv;
                *(u32x2*)(QB + (size_t)(rowbase + 32 * half + 16 * mt + fr) * 1024 + head * 64 + 16 * nt + 4 * fq) = (u32x2){cvt_pk_bf16(o[0], o[1]), cvt_pk_bf16(o[2], o[3])}; } }
    }
    __syncthreads();
  }
#undef SWA_FETCH
}

__device__ __forceinline__ void phase6(const Args& a, int bid, int G) {
    const int tid = threadIdx.x, lane = tid & 63, wave = tid >> 6;
    const int gw = bid * 8 + wave, NGW = G * 8;
    f32x4 lw[4], lb[4];
#pragma unroll
    for (int j = 0; j < 4; ++j) { lw[j] = ((const f32x4*)a.ln_w)[lane + 64 * j]; lb[j] = ((const f32x4*)a.ln_b)[lane + 64 * j]; }
    for (int row = gw; row < MR; row += NGW) {
        f32x4* p = (f32x4*)(a.out + (size_t)row * 1024) + lane;
        f32x4 v[4]; float s = 0.f;
#pragma unroll
        for (int j = 0; j < 4; ++j) { v[j] = p[64 * j]; s += (v[j][0] + v[j][1]) + (v[j][2] + v[j][3]); }
        const float mean = wave_sum(s) * (1.f / 1024.f); float s2 = 0.f;
#pragma unroll
        for (int j = 0; j < 4; ++j) { v[j] = v[j] - mean; s2 += (v[j][0] * v[j][0] + v[j][1] * v[j][1]) + (v[j][2] * v[j][2] + v[j][3] * v[j][3]); }
        const float rstd = rsqrtf(wave_sum(s2) * (1.f / 1024.f) + 1e-5f);
#pragma unroll
        for (int j = 0; j < 4; ++j) p[64 * j] = v[j] * rstd * lw[j] + lb[j];
    }
}

#define XB_TMO      128
#define XB_XCNT(j)  (256  + 64 * (j))
#define XB_XSUB(j)  (1280 + 64 * (j))
#define XB_XGEN(j)  (2304 + 64 * (j))
#define XB_TOP      3328
#define XB_TOPGEN   3392
#define XCD_BAR_WORDS 3456
#define XB_SPIN_CAP (1u << 22)
__device__ __forceinline__ unsigned xb_ld(unsigned* p)              { return __hip_atomic_load(p, __ATOMIC_RELAXED, __HIP_MEMORY_SCOPE_AGENT); }
__device__ __forceinline__ unsigned xb_add(unsigned* p, unsigned v) { return __hip_atomic_fetch_add(p, v, __ATOMIC_RELAXED, __HIP_MEMORY_SCOPE_AGENT); }
__device__ __forceinline__ unsigned xb_xcc_id() { return (unsigned)__builtin_amdgcn_s_getreg((3 << 11) | 20) & 0xFu; }
#define XB_SPIN(cond, bar) do { unsigned _sp = 0; while (cond) { __builtin_amdgcn_s_sleep(1); \
    if ((++_sp & 255u) == 0u) { if (xb_ld(&(bar)[XB_TMO])) break; if (_sp > XB_SPIN_CAP) { atomicAdd(&(bar)[XB_TMO], 1u); break; } } } } while (0)
struct XcdBarrier { unsigned* bar; unsigned x; volatile LAS unsigned* st; };
__device__ __forceinline__ XcdBarrier xcd_barrier_post(unsigned* bar, volatile LAS unsigned* st) {
    XcdBarrier b; b.bar = bar; b.x = xb_xcc_id(); b.st = st;
    if (threadIdx.x == 0) (void)xb_add(&bar[XB_XCNT(b.x)], 1u);
    return b;
}
__device__ __forceinline__ void xcd_barrier_complete(unsigned* bar, unsigned x, unsigned& nloc, unsigned& nx) {
    const unsigned G = gridDim.x * gridDim.y * gridDim.z;
    unsigned sum, cnt, mine, sp = 0u;
    for (;;) {
        sum = 0u; cnt = 0u; mine = 0u;
#pragma unroll
        for (unsigned j = 0; j < 16; ++j) { const unsigned c = xb_ld(&bar[XB_XCNT(j)]); sum += c; cnt += (c > 0u) ? 1u : 0u; mine = (j == x) ? c : mine; }
        if (sum == G) break;
        __builtin_amdgcn_s_sleep(1);
        if ((++sp & 255u) == 0u) { if (xb_ld(&bar[XB_TMO])) break; if (sp > XB_SPIN_CAP) { atomicAdd(&bar[XB_TMO], 1u); break; } }
    }
    nloc = mine > 0u ? mine : 1u; nx = cnt > 0u ? cnt : 1u;
}
__device__ __forceinline__ void xcd_barrier(const XcdBarrier& b) {
    asm volatile("s_waitcnt vmcnt(0)" ::: "memory");
    __syncthreads();
    if (threadIdx.x == 0) {
        unsigned* bar = b.bar;
        __builtin_amdgcn_s_waitcnt(0);
        unsigned nloc = b.st[0], nx = b.st[1];
        if (nloc == 0u) { xcd_barrier_complete(bar, b.x, nloc, nx); b.st[0] = nloc; b.st[1] = nx; }
        const unsigned old = xb_add(&bar[XB_XSUB(b.x)], 1u);
        const unsigned gen = old / nloc;
        if (old + 1u == (gen + 1u) * nloc) {
            __builtin_amdgcn_fence(__ATOMIC_RELEASE, "agent");
            asm volatile("s_waitcnt vmcnt(0)" ::: "memory");
            const unsigned og = xb_add(&bar[XB_TOP], 1u);
            const unsigned tg = og / nx;
            if (og + 1u == (tg + 1u) * nx) xb_add(&bar[XB_TOPGEN], 1u);
            else XB_SPIN(xb_ld(&bar[XB_TOPGEN]) == tg, bar);
            __builtin_amdgcn_fence(__ATOMIC_ACQUIRE, "agent");
            xb_add(&bar[XB_XGEN(b.x)], 1u);
            asm volatile("s_waitcnt vmcnt(0)" ::: "memory");
        } else {
            XB_SPIN(xb_ld(&bar[XB_XGEN(b.x)]) == gen, bar);
            __builtin_amdgcn_fence(__ATOMIC_ACQUIRE, "agent");
            asm volatile("s_waitcnt vmcnt(0)" ::: "memory");
        }
    }
    __syncthreads();
}
__global__ void __launch_bounds__(512, 2) hybrid_fwd(Args a) {
    extern __shared__ __attribute__((aligned(16))) unsigned char lds_raw[];
    LAS unsigned char* lds = (LAS unsigned char*)lds_raw;
    cg::grid_group grid = cg::this_grid();
    const int G = gridDim.x, bid = blockIdx.x;
    volatile LAS unsigned* bst = (volatile LAS unsigned*)(lds + LDS_BYTES - 64);
    if (threadIdx.x < 16) bst[threadIdx.x] = 0u;
    __syncthreads();
    XcdBarrier bar = xcd_barrier_post((unsigned*)(a.ws + WS_CTL), bst);
    grid.sync();
    bf16_t* HB = (bf16_t*)a.out;
    bf16_t* QA = (bf16_t*)(a.ws + WS_QA); bf16_t* KA = (bf16_t*)(a.ws + WS_KA); bf16_t* VA = (bf16_t*)(a.ws + WS_VA); bf16_t* QB = (bf16_t*)(a.ws + WS_QB);
    bf16_t* KVB = (bf16_t*)(a.ws + WS_KVB); bf16_t* WBUF = (bf16_t*)(a.ws + WS_WBUF);

#ifndef ONLY
#define ONLY -1
#endif
#define PH(k) (ONLY < 0 || ONLY == (k))
    if (PH(0)) phase0(a, lds, bid, G);
    xcd_barrier(bar);
    if (PH(1)) {
        pg8::Gemm g{HB, (const bf16_t*)(a.ws + WS_WT1), MP, 4608, 1024, 0, HB, 1024, 16}; pg8::StaticOrder S; S.init(MP, 4608, G, bid);
        EpiP1 E{QA, KA, VA, QB, KVB, (bf16_t*)(a.ws + WS_HALO)};
        pg8::gemm_phase<EpiP1, true>(lds, g, S, E);
    }
    xcd_barrier(bar);
    if (PH(2)) phase2a(a, lds, bid, G);
    xcd_barrier(bar);
    if (PH(3)) for (int sid = bid; sid < 256; sid += G) scan_item(a, lds, sid);
    if (PH(4)) swa_items(a, lds, bid, G);
    xcd_barrier(bar);
#ifdef DIAG
    {
        const bf16_t* B0 = (const bf16_t*)(a.ws + (DIAG == 1 ? WS_VA : DIAG == 2 ? WS_QB : DIAG == 3 ? WS_QA : DIAG == 4 ? WS_KA : DIAG == 5 ? WS_WBUF : WS_VA));
        for (size_t i = (size_t)bid * 512 + threadIdx.x; i < (size_t)MR * 1024; i += (size_t)G * 512) { const int R = (int)(i >> 10), c = (int)(i & 1023); float v = bf2f(B0[(size_t)real2pad(R) * 1024 + c]);
            if (DIAG == 6) { v = bf2f(((const bf16_t*)(a.ws + WS_QA))[(size_t)real2pad(R) * 1024 + c]) + 2.f * bf2f(((const bf16_t*)(a.ws + WS_KA))[(size_t)real2pad(R) * 1024 + c]);
                if (i < (size_t)2112 * 4096) v += 4.f * bf2f(((const bf16_t*)(a.ws + WS_ATT))[i]); if (i < 2112) v += ((const float*)(a.ws + WS_GL))[i]; }
            a.out[i] = v; }
        return;
    }
#endif
    if (PH(5)) {
        pg8::Gemm g{HB, (const bf16_t*)(a.ws + WS_WT2), MR, 4096, 1024, 1, HB, 1024, 16}; pg8::StaticOrder S; S.init(MR, 4096, G, bid);
        EpiP3 E{VA, QB, QA, KA, (const float*)(a.ws + WS_SSQ), a.gdn_norm_w, a.b_gate};
        pg8::gemm_phase<EpiP3, true>(lds, g, S, E);
    }
    xcd_barrier(bar);
    if (PH(6)) {
        pg8::StaticOrder S; S.init(MR, 1024, G, bid);
        pg8::Gemm g{VA, (const bf16_t*)(a.ws + WS_WA), MR, 1024, 2048, 1, QB, 1024, 16};
        EpiP4 E{QA, KA, WBUF};
        pg8::gemm_phase<EpiP4, true>(lds, g, S, E);
    }
    xcd_barrier(bar);
    if (PH(7)) {
        pg8::Gemm g{WBUF, (const bf16_t*)(a.ws + WS_WO), MR, 1024, 1024, 0, WBUF, 1024, 16}; pg8::StaticOrder S; S.init(MR, 1024, G, bid);
        EpiP5 E{a.x, a.out};
        pg8::gemm_phase<EpiP5, true>(lds, g, S, E);
    }
    xcd_barrier(bar);
    if (PH(8)) phase6(a, bid, G);
}

extern "C" void kernel_launch(void* const* d_in, const int* in_sizes, int n_in, void* d_out, int out_size, void* d_ws, size_t ws_size, hipStream_t stream) {
    static int grid = 0;
    if (grid == 0) {
        if (n_in != 14 || ws_size < WS_CTL + CTL_BYTES) { fprintf(stderr, "kernel_launch: unexpected inputs (n_in %d, ws %zu)\n", n_in, ws_size); grid = -1; return; }
        int dev = 0, cus = 0, per_cu = 0;
        hipGetDevice(&dev); hipDeviceGetAttribute(&cus, hipDeviceAttributeMultiprocessorCount, dev);
        hipFuncSetAttribute((const void*)hybrid_fwd, hipFuncAttributeMaxDynamicSharedMemorySize, LDS_BYTES);
        hipOccupancyMaxActiveBlocksPerMultiprocessor(&per_cu, (const void*)hybrid_fwd, 512, LDS_BYTES);
        if (per_cu < 1) { fprintf(stderr, "kernel_launch: occupancy query reports %d blocks per CU\n", per_cu); per_cu = 1; }
        grid = cus;
        fprintf(stderr, "kernel_launch: cus %d per_cu %d grid %d\n", cus, per_cu, grid);
    }
    if (grid < 0) return;
    Args a{};
    a.x = (const float*)d_in[0]; a.meta = (const float*)d_in[1]; a.w_in = (const float*)d_in[2]; a.b_gate = (const float*)d_in[3]; a.conv_w = (const float*)d_in[4];
    a.a_log = (const float*)d_in[5]; a.dt_bias = (const float*)d_in[6]; a.gdn_norm_w = (const float*)d_in[7]; a.sinks = (const float*)d_in[8];
    a.w_proj_a = (const float*)d_in[9]; a.w_proj_b = (const float*)d_in[10]; a.w_out = (const float*)d_in[11]; a.ln_w = (const float*)d_in[12]; a.ln_b = (const float*)d_in[13];
    a.out = (float*)d_out; a.ws = (unsigned char*)d_ws;
    if (hipMemsetAsync((char*)d_ws + WS_CTL, 0, CTL_BYTES, stream) != hipSuccess) { fprintf(stderr, "kernel_launch: memset failed\n"); return; }
    void* args[] = {&a};
    hipError_t e = hipLaunchCooperativeKernel((const void*)hybrid_fwd, dim3(grid), dim3(512), args, LDS_BYTES, stream);
    if (e != hipSuccess) fprintf(stderr, "cooperative launch failed: %s (grid %d)\n", hipGetErrorString(e), grid);
}
```

```cpp
#include <hip/hip_runtime.h>
#include <hip/hip_cooperative_groups.h>
#include <cstdio>
#include <cstdint>
namespace cg = cooperative_groups;

#define LAS __attribute__((address_space(3)))
typedef unsigned short bf16_t;
typedef short bf16x8 __attribute__((ext_vector_type(8)));
typedef short bf16x4 __attribute__((ext_vector_type(4)));
typedef float f32x4 __attribute__((ext_vector_type(4)));
typedef float f32x2 __attribute__((ext_vector_type(2)));
typedef unsigned u32x4 __attribute__((ext_vector_type(4)));
typedef unsigned u32x2 __attribute__((ext_vector_type(2)));

constexpr int NB = 8, SEQ = 2048, DM = 1024, LP = 2112, NCH = 33, MP = NB * LP  , MR = NB * SEQ  ;
constexpr int NWIN = 8720;
constexpr float DN_ALPHA = 1.189207115002721f;
constexpr float LOG2E = 1.4426950408889634f;

constexpr size_t SZ_S1 = (size_t)MP * 1024 * 2;
constexpr size_t WS_WT1 = 0;
constexpr size_t WS_WT2 = WS_WT1 + (size_t)4608 * 1024 * 2;
constexpr size_t WS_WA = WS_WT2 + (size_t)4096 * 1024 * 2;
constexpr size_t WS_WB = WS_WA + (size_t)1024 * 1024 * 2;
constexpr size_t WS_WO = WS_WB + (size_t)1024 * 1024 * 2;
constexpr size_t WS_BD = WS_WO + (size_t)1024 * 1024 * 2;
constexpr size_t WS_GL = WS_BD + (size_t)MP * 16 * 4;
constexpr size_t WS_SSQ = WS_GL + 16384;
constexpr size_t WS_HALO = WS_SSQ + (size_t)MP * 64 * 4;
constexpr size_t WS_QA = WS_HALO + (size_t)264 * 3 * 3072 * 2;
constexpr size_t WS_KA = WS_QA + SZ_S1;
constexpr size_t WS_VA = WS_KA + SZ_S1;
constexpr size_t WS_QB = WS_VA + SZ_S1;
constexpr size_t WS_KVB = WS_QB + SZ_S1;
constexpr size_t WS_WBUF = WS_KVB + (size_t)MP * 512 * 2;
constexpr size_t WS_ATT = WS_WBUF + SZ_S1;
constexpr size_t WS_END = WS_ATT + (size_t)2112 * 4096 * 2;
constexpr size_t WS_CTL = WS_END;
constexpr size_t CTL_BYTES = 16384;
static_assert(WS_CTL + CTL_BYTES <= 268435456 && WS_CTL % 256 == 0, "workspace map");

constexpr int LDS_BYTES = 147456;

typedef __bf16 bf16x2_t __attribute__((ext_vector_type(2)));
__device__ __forceinline__ unsigned cvt_pk_bf16(float lo, float hi) { const f32x2 v = {lo, hi}; return __builtin_bit_cast(unsigned, __builtin_convertvector(v, bf16x2_t)); }
__device__ __forceinline__ float bf_lo(unsigned w) { return __uint_as_float(w << 16); }
__device__ __forceinline__ float bf_hi(unsigned w) { return __uint_as_float(w & 0xffff0000u); }
__device__ __forceinline__ float bf2f(bf16_t b) { return __uint_as_float(((unsigned)b) << 16); }
__device__ __forceinline__ float sigmoidf_(float x) { return __builtin_amdgcn_rcpf(1.f + __expf(-x)); }
__device__ __forceinline__ float siluf_(float x) { return x * sigmoidf_(x); }
__device__ __forceinline__ float wave_sum(float v) {
#pragma unroll
    for (int o = 1; o < 64; o <<= 1) v += __shfl_xor(v, o);
    return v;
}
__device__ __forceinline__ float wave_sum_dpp(float v) {
    v += __builtin_bit_cast(float, __builtin_amdgcn_update_dpp(0, __builtin_bit_cast(int, v), 0xB1, 0xF, 0xF, true));
    v += __builtin_bit_cast(float, __builtin_amdgcn_update_dpp(0, __builtin_bit_cast(int, v), 0x4E, 0xF, 0xF, true));
    v += __builtin_bit_cast(float, __builtin_amdgcn_update_dpp(0, __builtin_bit_cast(int, v), 0x141, 0xF, 0xF, true));
    v += __builtin_bit_cast(float, __builtin_amdgcn_update_dpp(0, __builtin_bit_cast(int, v), 0x140, 0xF, 0xF, true));
    const int vi = __builtin_bit_cast(int, v);
    return (__builtin_bit_cast(float, __builtin_amdgcn_readlane(vi, 0)) + __builtin_bit_cast(float, __builtin_amdgcn_readlane(vi, 16)))
         + (__builtin_bit_cast(float, __builtin_amdgcn_readlane(vi, 32)) + __builtin_bit_cast(float, __builtin_amdgcn_readlane(vi, 48)));
}
#define LDS_WAIT() asm volatile("s_waitcnt lgkmcnt(0)" ::: "memory")

namespace pg8 {
constexpr int BM = 256, BK = 64, HALF = 128, HTB = HALF * BK * 2, STAGE_BYTES = 8 * HTB, NXCD = 8, WGM = 8;
__host__ __device__ __forceinline__ int lds_byte(int r, int c) { const int st = (r >> 4) * 2 + (c >> 5), rr = r & 15, cc = c & 31, ob = rr * 64 + cc * 2; return st * 1024 + (ob ^ (((ob >> 9) & 1) << 5)); }
__host__ __device__ __forceinline__ void stage_rc(int b, int& R, int& C) { const int st = b / 1024, sb = b % 1024, swz = sb ^ (((sb >> 9) & 1) << 5); R = (st >> 1) * 16 + swz / 64; C = (st & 1) * 32 + (swz % 64) / 2; }
__host__ __device__ __forceinline__ int perm32(int rho) { const int n = rho >> 4, i = rho & 15; return 8 * (i >> 2) + 4 * n + (i & 3); }
struct Unit { int pm, pn; };
struct Gemm { const bf16_t* A; const bf16_t* Bt; int M, N, K, amode; const bf16_t* A2; int lda, split;
    __device__ __forceinline__ size_t aoffs(int pm) const { const int r = amode ? ((pm >> 3) * LP + 64 + (pm & 7) * 256) : pm * 256; return (size_t)r * lda * 2; } };
struct StaticOrder {
    int nM, nN, nwg, G, c;
    __host__ __device__ void init(int M, int N, int G_, int c_) { nM = M / BM; nN = N / BM; nwg = nM * nN; G = G_; c = c_; }
    __host__ __device__ bool next(int i, Unit& u) const {
        const long L = (long)i * G + c; if (L >= nwg) return false;
        int wgid = (int)L; { const int q = nwg / NXCD, r = nwg % NXCD, xcd = wgid % NXCD, off = wgid / NXCD; wgid = (xcd < r ? xcd * (q + 1) : r * (q + 1) + (xcd - r) * q) + off; }
        const int nig = WGM * nN, gid = wgid / nig, fm = gid * WGM, gsz = (nM - fm) < WGM ? (nM - fm) : WGM;
        u.pm = fm + ((wgid % nig) % gsz); u.pn = (wgid % nig) / gsz; return true;
    }
};
template <class Epi, bool ALIGN_EPI>
__device__ __forceinline__ void gemm_phase(LAS unsigned char* lds, const Gemm g, const StaticOrder& S, const Epi& E) {
    int tid = threadIdx.x; asm volatile("" : "+v"(tid));
    const int wid = __builtin_amdgcn_readfirstlane(tid >> 6), lane = tid & 63, wr = wid >> 2, wc = wid & 3, fr = lane & 15, fq = lane >> 4;
    const int K = g.K, nt = K / BK;
    unsigned voffA[2], voffB[2];
#pragma unroll
    for (int i = 0; i < 2; ++i) { int R, C; stage_rc(tid * 16 + i * 8192, R, C); const int Rb = (R & ~31) + perm32(R & 31);
        voffA[i] = (unsigned)(R * g.lda + C) * 2u; voffB[i] = (unsigned)(Rb * K + C) * 2u; }
    const size_t kstep = (size_t)(BK * 2);
    const size_t hstep = (size_t)HALF * K * 2;
    const size_t hstepA = (size_t)HALF * g.lda * 2;
    const size_t tstep = 2 * hstep;
    const int split = g.split; const ptrdiff_t a2d = ((const char*)g.A2 - (const char*)g.A) - (ptrdiff_t)split * (ptrdiff_t)kstep;
#define PG8_AK(base, t) ((base) + ((t) < split ? (ptrdiff_t)0 : a2d) + (size_t)(t) * kstep)
    const unsigned ldsw = (unsigned)wid * 1024u;
    const int aoff = lds_byte(wr * 64 + fr, fq * 8), boff = lds_byte(wc * 32 + fr, fq * 8);
#define PG8_SA(b, h) (((b) * 2 + (h)) * HTB)
#define PG8_SB(b, h) ((4 + (b) * 2 + (h)) * HTB)
#define PG8_STAGE(bufoff, gbase, voff) do { _Pragma("unroll") for (int _i = 0; _i < 2; ++_i) \
        __builtin_amdgcn_global_load_lds((const unsigned*)((const char*)(gbase) + (voff)[_i]), (LAS unsigned*)(lds + (bufoff) + ldsw + _i * 8192), 16, 0, 0); } while (0)
#define PG8_LDA(dst, b, h) do { _Pragma("unroll") for (int m = 0; m < 4; ++m) _Pragma("unroll") for (int k = 0; k < 2; ++k) dst[m][k] = *(const LAS bf16x8*)(lds + PG8_SA(b, h) + aoff + m * 2048 + k * 1024); } while (0)
#define PG8_LDB(dst, b, h) do { _Pragma("unroll") for (int n = 0; n < 2; ++n) _Pragma("unroll") for (int k = 0; k < 2; ++k) dst[n][k] = *(const LAS bf16x8*)(lds + PG8_SB(b, h) + boff + n * 2048 + k * 1024); } while (0)
#define PG8_MMA(ai, bj, At, Bt) do { __builtin_amdgcn_s_setprio(1); _Pragma("unroll") for (int m = 0; m < 4; ++m) _Pragma("unroll") for (int n = 0; n < 2; ++n) _Pragma("unroll") for (int k = 0; k < 2; ++k) \
        acc[ai][bj][m][n] = __builtin_amdgcn_mfma_f32_16x16x32_bf16(Bt[n][k], At[m][k], acc[ai][bj][m][n], 0, 0, 0); __builtin_amdgcn_s_setprio(0); } while (0)
#define PG8_WAIT_V(n) asm volatile("s_waitcnt vmcnt(" #n ")" ::: "memory")
#define PG8_WAIT_L(n) asm volatile("s_waitcnt lgkmcnt(" #n ")" ::: "memory")
#define PG8_BAR __builtin_amdgcn_s_barrier()
#define PG8_SCHED __builtin_amdgcn_sched_barrier(0)
    Unit cur, nxt; int ui = 0;
    if (!S.next(0, cur)) return;
    f32x4 acc[2][2][4][2];
#pragma unroll
    for (int a = 0; a < 2; ++a)
#pragma unroll
        for (int b = 0; b < 2; ++b)
#pragma unroll
            for (int m = 0; m < 4; ++m)
#pragma unroll
                for (int n = 0; n < 2; ++n) acc[a][b][m][n] = (f32x4){0.f, 0.f, 0.f, 0.f};
    bf16x8 At[4][2], B0[2][2], B1[2][2];
    const char* cA = (const char*)g.A + g.aoffs(cur.pm); const char* cB = (const char*)g.Bt + (size_t)cur.pn * tstep;
    PG8_STAGE(PG8_SB(0, 0), cB, voffB); PG8_STAGE(PG8_SB(0, 1), cB + hstep, voffB); PG8_STAGE(PG8_SA(0, 0), cA, voffA); PG8_STAGE(PG8_SA(0, 1), cA + hstepA, voffA);
    if (wr == 1) PG8_BAR;
    PG8_WAIT_V(2); PG8_BAR;
    PG8_STAGE(PG8_SB(1, 0), cB + kstep, voffB); PG8_STAGE(PG8_SA(1, 0), PG8_AK(cA, 1), voffA); PG8_STAGE(PG8_SB(1, 1), cB + hstep + kstep, voffB);
    PG8_WAIT_V(6); PG8_BAR;
    for (;;) {
        const bool has_next = S.next(ui + 1, nxt);
        const char* nA = has_next ? (const char*)g.A + g.aoffs(nxt.pm) : cA; const char* nB = has_next ? (const char*)g.Bt + (size_t)nxt.pn * tstep : cB;
        for (int t = 0; t < nt; t += 2) {
            const bool last = (t == nt - 2);
            const char* a1 = PG8_AK(cA, t + 1);
            const char* a2 = last ? nA : PG8_AK(cA, t + 2); const char* b2 = last ? nB : cB + (size_t)(t + 2) * kstep;
            const char* a3 = last ? PG8_AK(nA, 1) : PG8_AK(cA, t + 3); const char* b3 = b2 + kstep;
            PG8_LDB(B0, 0, 0); PG8_LDB(B1, 0, 1); PG8_SCHED; PG8_LDA(At, 0, 0); PG8_STAGE(PG8_SA(1, 1), a1 + hstepA, voffA);
            PG8_WAIT_V(8); PG8_WAIT_L(0); PG8_BAR; PG8_MMA(0, 0, At, B0); PG8_MMA(0, 1, At, B1); PG8_BAR; PG8_SCHED;
            PG8_LDA(At, 0, 1); PG8_STAGE(PG8_SB(0, 0), b2, voffB); PG8_STAGE(PG8_SB(0, 1), b2 + hstep, voffB); PG8_STAGE(PG8_SA(0, 0), a2, voffA);
            PG8_WAIT_V(8); PG8_WAIT_L(0); PG8_BAR; PG8_MMA(1, 0, At, B0); PG8_MMA(1, 1, At, B1); PG8_BAR; PG8_SCHED;
            PG8_LDB(B0, 1, 0); PG8_LDB(B1, 1, 1); PG8_SCHED; PG8_LDA(At, 1, 0); PG8_STAGE(PG8_SA(0, 1), a2 + hstepA, voffA);
            PG8_WAIT_V(8); PG8_WAIT_L(0); PG8_BAR; PG8_MMA(0, 0, At, B0); PG8_MMA(0, 1, At, B1); PG8_BAR; PG8_SCHED;
            PG8_LDA(At, 1, 1); PG8_STAGE(PG8_SB(1, 0), b3, voffB); PG8_STAGE(PG8_SB(1, 1), b3 + hstep, voffB); PG8_STAGE(PG8_SA(1, 0), a3, voffA);
            PG8_WAIT_V(8); PG8_WAIT_L(0); PG8_BAR; PG8_MMA(1, 0, At, B0); PG8_MMA(1, 1, At, B1); PG8_BAR; PG8_SCHED;
            if constexpr (Epi::MIDK) { if (t + 2 == split) { PG8_WAIT_V(0); E.mid(acc, cur, wr, wc, fr, fq); PG8_WAIT_V(0); PG8_SCHED; } }
        }
        if constexpr (ALIGN_EPI) { if (wr == 0) PG8_BAR; }
        E(acc, cur, wr, wc, fr, fq);
        if (!has_next) break;
#pragma unroll
        for (int a = 0; a < 2; ++a)
#pragma unroll
            for (int b = 0; b < 2; ++b)
#pragma unroll
                for (int m = 0; m < 4; ++m)
#pragma unroll
                    for (int n = 0; n < 2; ++n) acc[a][b][m][n] = (f32x4){0.f, 0.f, 0.f, 0.f};
        cur = nxt; cA = nA; cB = nB; ++ui;
        if constexpr (ALIGN_EPI) { if (wr == 1) PG8_BAR; }
    }
    PG8_WAIT_V(0);
    if constexpr (!ALIGN_EPI) { if (wr == 0) PG8_BAR; }
    PG8_BAR;
#undef PG8_AK
#undef PG8_SA
#undef PG8_SB
#undef PG8_STAGE
#undef PG8_LDA
#undef PG8_LDB
#undef PG8_MMA
#undef PG8_WAIT_V
#undef PG8_WAIT_L
#undef PG8_BAR
#undef PG8_SCHED
}
}

__device__ __forceinline__ void st16_wt(const __amdgpu_buffer_rsrc_t rs, const void* base, const void* p, const u32x4 v) {
    __builtin_amdgcn_raw_buffer_store_b128(v, rs, (unsigned)((const char*)p - (const char*)base), 0, 16); }
__device__ __forceinline__ void st8_wt(const __amdgpu_buffer_rsrc_t rs, const void* base, const void* p, const u32x2 v) {
    __builtin_amdgcn_raw_buffer_store_b64(v, rs, (unsigned)((const char*)p - (const char*)base), 0, 16); }
#define WS_RSRC(ws_) __builtin_amdgcn_make_buffer_rsrc((ws_), 0, 0x10000000, 0x00020000)
#define OUT_RSRC(o_) __builtin_amdgcn_make_buffer_rsrc((o_), 0, 0x04000000, 0x00020000)
typedef const f32x4 (&AccRef)[2][2][4][2];
__device__ __forceinline__ u32x4 pack8(const f32x4 a, const f32x4 b) { u32x4 w; w.x = cvt_pk_bf16(a[0], a[1]); w.y = cvt_pk_bf16(a[2], a[3]); w.z = cvt_pk_bf16(b[0], b[1]); w.w = cvt_pk_bf16(b[2], b[3]); return w; }
__device__ __forceinline__ void unpack8(const u32x4 w, float (&o)[8]) { o[0] = bf_lo(w.x); o[1] = bf_hi(w.x); o[2] = bf_lo(w.y); o[3] = bf_hi(w.y); o[4] = bf_lo(w.z); o[5] = bf_hi(w.z); o[6] = bf_lo(w.w); o[7] = bf_hi(w.w); }
__device__ __forceinline__ int real2pad(int R) { return (R >> 11) * LP + 64 + (R & 2047); }

struct EpiP1 {
    static constexpr bool MIDK = false;
    bf16_t *QA, *KA, *VA, *QB, *KVB, *HALO; unsigned char* WS;
    __device__ __forceinline__ void operator()(AccRef acc, const pg8::Unit& u, int wr, int wc, int fr, int fq) const {
        const __amdgpu_buffer_rsrc_t rs = __builtin_amdgcn_make_buffer_rsrc(WS, 0, 0x10000000, 0x00020000);
        const int seg = u.pn >> 2; bf16_t* base; int ld, c0;
        if (seg < 4) { base = seg == 0 ? QA : (seg == 1 ? KA : (seg == 2 ? VA : QB)); ld = 1024; c0 = (u.pn & 3) * 256; } else { base = KVB; ld = 512; c0 = (u.pn - 16) * 256; }
        const int col0 = c0 + wc * 32 + 8 * fq;
#pragma unroll
        for (int ai = 0; ai < 2; ++ai)
#pragma unroll
            for (int m = 0; m < 4; ++m) { const int row = u.pm * 256 + ai * 128 + wr * 64 + m * 16 + fr;
#pragma unroll
                for (int bj = 0; bj < 2; ++bj) { const u32x4 w = pack8(acc[ai][bj][m][0], acc[ai][bj][m][1]);
                    st16_wt(rs, WS, base + (size_t)row * ld + col0 + bj * 128, w);
                    if (m == 3) { if (seg < 3 && fr >= 13) st16_wt(rs, WS, HALO + ((size_t)(row >> 6) * 3 + (fr - 13)) * 3072 + seg * 1024 + col0 + bj * 128, w); } } }
    }
};
struct EpiP3 {
    static constexpr bool MIDK = false;
    bf16_t *YA, *YB, *GA, *GB; const float *SSQ, *normw, *bgate; unsigned char* WS;
    __device__ __forceinline__ void operator()(AccRef acc, const pg8::Unit& u, int wr, int wc, int fr, int fq) const {
        const __amdgpu_buffer_rsrc_t rsw = WS_RSRC(WS);
        const int seg = u.pn >> 2, c0 = (u.pn & 3) * 256, col0 = c0 + wc * 32 + 8 * fq;
        if (seg >= 2) {
            bf16_t* G = seg == 2 ? GA : GB; const float* bg = bgate + (seg - 2) * 1024;
            f32x4 bv[2][2];
#pragma unroll
            for (int bj = 0; bj < 2; ++bj) { bv[bj][0] = *(const f32x4*)(bg + col0 + bj * 128); bv[bj][1] = *(const f32x4*)(bg + col0 + bj * 128 + 4); }
#pragma unroll
            for (int ai = 0; ai < 2; ++ai)
#pragma unroll
                for (int m = 0; m < 4; ++m) { const int R = u.pm * 256 + ai * 128 + wr * 64 + m * 16 + fr;
#pragma unroll
                    for (int bj = 0; bj < 2; ++bj) { f32x4 v0 = acc[ai][bj][m][0] + bv[bj][0], v1 = acc[ai][bj][m][1] + bv[bj][1];
#pragma unroll
                        for (int e = 0; e < 4; ++e) { v0[e] = sigmoidf_(v0[e]); v1[e] = sigmoidf_(v1[e]); }
                        st16_wt(rsw, WS, G + (size_t)R * 1024 + col0 + bj * 128, pack8(v0, v1)); } }
        } else {
            bf16_t* Y = seg == 0 ? YA : YB;
            float nw[8];
#pragma unroll
            for (int e = 0; e < 8; ++e) nw[e] = seg == 0 ? normw[wc * 32 + 8 * fq + e] : 1.f;
#pragma unroll
            for (int ai = 0; ai < 2; ++ai)
#pragma unroll
                for (int m = 0; m < 4; ++m) { const int R = u.pm * 256 + ai * 128 + wr * 64 + m * 16 + fr; const int prow = real2pad(R);
#pragma unroll
                    for (int bj = 0; bj < 2; ++bj) {
                        float rs = 1.f;
                        if (seg == 0) { const int head = (u.pn & 3) * 2 + bj; const f32x4* sp = (const f32x4*)(SSQ + ((size_t)prow * 8 + head) * 8); const f32x4 s0 = sp[0], s1 = sp[1];
                            const float ss = (s0[0] + s0[1]) + (s0[2] + s0[3]) + (s1[0] + s1[1]) + (s1[2] + s1[3]); rs = rsqrtf(ss * (1.f / 128.f) + 1e-6f); }
                        bf16_t* p = Y + (size_t)prow * 1024 + col0 + bj * 128; const u32x4 ow = *(const u32x4*)p; float o[8]; unpack8(ow, o);
                        f32x4 v0, v1;
#pragma unroll
                        for (int e = 0; e < 4; ++e) { v0[e] = o[e] * rs * nw[e] * siluf_(acc[ai][bj][m][0][e]); v1[e] = o[4 + e] * rs * nw[4 + e] * siluf_(acc[ai][bj][m][1][e]); }
                        *(u32x4*)p = pack8(v0, v1); } }
        }
    }
};
struct EpiP4 {
    static constexpr bool MIDK = true;
    const bf16_t *GA, *GB; bf16_t* MIX; unsigned char* WS;
    __device__ __forceinline__ void mid(f32x4 (&acc)[2][2][4][2], const pg8::Unit& u, int wr, int wc, int fr_, int fq) const {
        int fr = fr_; asm volatile("" : "+v"(fr));
        const int col0 = u.pn * 256 + wc * 32 + 8 * fq;
#pragma unroll
        for (int ai = 0; ai < 2; ++ai)
#pragma unroll
            for (int m = 0; m < 4; ++m) { const size_t R = u.pm * 256 + ai * 128 + wr * 64 + m * 16 + fr;
#pragma unroll
                for (int bj = 0; bj < 2; ++bj) { const size_t off = R * 1024 + col0 + bj * 128; float ga[8], gb[8]; unpack8(*(const u32x4*)(GA + off), ga); unpack8(*(const u32x4*)(GB + off), gb);
#pragma unroll
                    for (int e = 0; e < 4; ++e) { acc[ai][bj][m][0][e] *= ga[e] * __builtin_amdgcn_rcpf(gb[e]); acc[ai][bj][m][1][e] *= ga[4 + e] * __builtin_amdgcn_rcpf(gb[4 + e]); } }
                asm volatile("" ::: "memory"); }
    }
    __device__ __forceinline__ void operator()(AccRef acc, const pg8::Unit& u, int wr, int wc, int fr, int fq) const {
        const int col0 = u.pn * 256 + wc * 32 + 8 * fq;
#pragma unroll
        for (int ai = 0; ai < 2; ++ai)
#pragma unroll
            for (int m = 0; m < 4; ++m) { const size_t R = u.pm * 256 + ai * 128 + wr * 64 + m * 16 + fr;
#pragma unroll
                for (int bj = 0; bj < 2; ++bj) { const size_t off = R * 1024 + col0 + bj * 128; float g[8]; unpack8(*(const u32x4*)(GB + off), g);
                    f32x4 v0, v1;
#pragma unroll
                    for (int e = 0; e < 4; ++e) { v0[e] = g[e] * acc[ai][bj][m][0][e]; v1[e] = g[4 + e] * acc[ai][bj][m][1][e]; }
                    st16_wt(WS_RSRC(WS), WS, MIX + off, pack8(v0, v1)); } }
    }
};
struct EpiP5 {
    static constexpr bool MIDK = false;
    const float* X; float* OUT;
    __device__ __forceinline__ void operator()(AccRef acc, const pg8::Unit& u, int wr, int wc, int fr, int fq) const {
        const int col0 = u.pn * 256 + wc * 32 + 8 * fq;
#pragma unroll
        for (int ai = 0; ai < 2; ++ai)
#pragma unroll
            for (int m = 0; m < 4; ++m) { const size_t R = u.pm * 256 + ai * 128 + wr * 64 + m * 16 + fr;
#pragma unroll
                for (int bj = 0; bj < 2; ++bj) { const size_t off = R * 1024 + col0 + bj * 128;
                    const f32x4 x0 = *(const f32x4*)(X + off), x1 = *(const f32x4*)(X + off + 4);
                    const f32x4 o0 = x0 * DN_ALPHA + acc[ai][bj][m][0], o1 = x1 * DN_ALPHA + acc[ai][bj][m][1];
                    *(f32x4*)(OUT + off) = o0; *(f32x4*)(OUT + off + 4) = o1; } }
    }
};

struct Args {
    const float *x, *meta, *w_in, *b_gate, *conv_w, *a_log, *dt_bias, *gdn_norm_w, *sinks, *w_proj_a, *w_proj_b, *w_out, *ln_w, *ln_b;
    float* out; unsigned char* ws;
};

__device__ __forceinline__ void transpose_item(const float* W, int ldw, int col0, bf16_t* WT, int row0, LAS float* scr, int item, int nblk, int lane, int ldt = 1024, int kc0 = 0) {
    const int kb = item / nblk, nb = item % nblk, k0 = 64 * kb, n0 = 32 * nb;
#pragma unroll 8
    for (int i = 0; i < 32; ++i) { const int kk = 2 * i + (lane >> 5); scr[kk * 33 + (lane & 31)] = W[(size_t)(k0 + kk) * ldw + col0 + n0 + (lane & 31)]; }
    LDS_WAIT(); asm volatile("" ::: "memory");
    const int c = lane & 7;
#pragma unroll
    for (int j = 0; j < 4; ++j) { const int n = (lane >> 3) + 8 * j; const LAS float* s = scr + (8 * c) * 33 + n;
        u32x4 o; o.x = cvt_pk_bf16(s[0 * 33], s[1 * 33]); o.y = cvt_pk_bf16(s[2 * 33], s[3 * 33]); o.z = cvt_pk_bf16(s[4 * 33], s[5 * 33]); o.w = cvt_pk_bf16(s[6 * 33], s[7 * 33]);
        *(u32x4*)(WT + (size_t)(row0 + n0 + n) * ldt + kc0 + k0 + 8 * c) = o; }
    LDS_WAIT(); asm volatile("" ::: "memory");
}

__device__ __forceinline__ void phase0(const Args& a, LAS unsigned char* lds, int bid, int G) {
    const int tid = threadIdx.x, lane = tid & 63, wave = tid >> 6;
    const int gw = bid * 8 + wave, NGW = G * 8;
    bf16_t* WT1 = (bf16_t*)(a.ws + WS_WT1); bf16_t* WT2 = (bf16_t*)(a.ws + WS_WT2);
    bf16_t* WA = (bf16_t*)(a.ws + WS_WA); bf16_t* WB = (bf16_t*)(a.ws + WS_WB); bf16_t* WO = (bf16_t*)(a.ws + WS_WO);
    LAS float* scr = (LAS float*)(lds + wave * 8704);
    constexpr int I0 = 16 * 96, I1 = 16 * 48, I2 = 16 * 32, I3 = 16 * 96, I4 = 16 * 32;
    constexpr int NIT = I0 + I1 + I2 + I3 + 3 * I4;
    for (int it = gw; it < NIT; it += NGW) {
        int r = it;
        if (r < I0) { transpose_item(a.w_in, NWIN, 0, WT1, 0, scr, r, 96, lane); continue; } r -= I0;
        if (r < I1) { transpose_item(a.w_in, NWIN, 4112, WT1, 3072, scr, r, 48, lane); continue; } r -= I1;
        if (r < I2) { transpose_item(a.w_in, NWIN, 3072, WT2, 0, scr, r, 32, lane); continue; } r -= I2;
        if (r < I3) { transpose_item(a.w_in, NWIN, 5648, WT2, 1024, scr, r, 96, lane); continue; } r -= I3;
        if (r < I4) { transpose_item(a.w_proj_a, 1024, 0, WA, 0, scr, r, 32, lane, 2048, 0); continue; } r -= I4;
        if (r < I4) { transpose_item(a.w_proj_b, 1024, 0, WA, 0, scr, r, 32, lane, 2048, 1024); continue; } r -= I4;
        transpose_item(a.w_out, 1024, 0, WO, 0, scr, r, 32, lane);
    }
    __syncthreads();
    LAS float* wl = (LAS float*)lds;
    for (int i = tid; i < 1024 * 16; i += 512) { const int k = i >> 4, c = i & 15; const int slot = ((k >> 8) * 4 + (k & 3)) * 64 + ((k & 255) >> 2);
        wl[slot * 20 + c] = a.w_in[(size_t)k * NWIN + 4096 + c]; }
    __syncthreads();
    bf16_t* HB = (bf16_t*)a.out; float* BD = (float*)(a.ws + WS_BD);
    for (int row = gw; row < MP; row += NGW) {
        const int b = row / LP, tp = row - b * LP;
        u32x2* hb8 = (u32x2*)(HB + (size_t)row * 1024);
        if (tp < 48) {
#pragma unroll
            for (int j = 0; j < 4; ++j) hb8[lane + 64 * j] = (u32x2){0u, 0u};
            if (lane < 16) BD[(size_t)row * 16 + lane] = 0.f;
            continue;
        }
        const float* src = tp < 64 ? a.meta + (size_t)(tp - 48) * 1024 : a.x + ((size_t)b * SEQ + (tp - 64)) * 1024;
        f32x4 v[4];
#pragma unroll
        for (int j = 0; j < 4; ++j) v[j] = ((const f32x4*)src)[lane + 64 * j];
#pragma unroll
        for (int j = 0; j < 4; ++j) hb8[lane + 64 * j] = (u32x2){cvt_pk_bf16(v[j][0], v[j][1]), cvt_pk_bf16(v[j][2], v[j][3])};
        float acc[16];
#pragma unroll
        for (int c = 0; c < 16; ++c) acc[c] = 0.f;
#pragma unroll
        for (int j = 0; j < 4; ++j)
#pragma unroll
            for (int e = 0; e < 4; ++e) { const LAS f32x4* wp = (const LAS f32x4*)(wl + ((j * 4 + e) * 64 + lane) * 20); const float hv = v[j][e];
#pragma unroll
                for (int c4 = 0; c4 < 4; ++c4) { const f32x4 w4 = wp[c4];
#pragma unroll
                    for (int q = 0; q < 4; ++q) acc[4 * c4 + q] += hv * w4[q]; } }
        float t8[8], t4[4], t2[2], t1;
        { const bool hi = lane & 32;
#pragma unroll
          for (int i = 0; i < 8; ++i) { const float send = hi ? acc[i] : acc[8 + i], keep = hi ? acc[8 + i] : acc[i]; t8[i] = keep + __shfl_xor(send, 32); } }
        { const bool hi = lane & 16;
#pragma unroll
          for (int i = 0; i < 4; ++i) { const float send = hi ? t8[i] : t8[4 + i], keep = hi ? t8[4 + i] : t8[i]; t4[i] = keep + __shfl_xor(send, 16); } }
        { const bool hi = lane & 8;
#pragma unroll
          for (int i = 0; i < 2; ++i) { const float send = hi ? t4[i] : t4[2 + i], keep = hi ? t4[2 + i] : t4[i]; t2[i] = keep + __shfl_xor(send, 8); } }
        { const bool hi = lane & 4; const float send = hi ? t2[0] : t2[1], keep = hi ? t2[1] : t2[0]; t1 = keep + __shfl_xor(send, 4); }
        t1 += __shfl_xor(t1, 2); t1 += __shfl_xor(t1, 1);
        const int idx = ((lane >> 5) & 1) * 8 + ((lane >> 4) & 1) * 4 + ((lane >> 3) & 1) * 2 + ((lane >> 2) & 1);
        if ((lane & 3) == 0) BD[(size_t)row * 16 + idx] = t1;
    }
}

constexpr int P2_QS = 0, P2_KS = 17408, P2_VS = 34816, P2_KF = 68608, P2_AM = 102400, P2_XO = 119808, P2_GC = 137216, P2_BETA = 137472, P2_EGC = 137728, P2_SCL = 137984;
__device__ __forceinline__ void phase2a(const Args& a, LAS unsigned char* lds, int bid, int G) {
    bf16_t* QA = (bf16_t*)(a.ws + WS_QA); bf16_t* KA = (bf16_t*)(a.ws + WS_KA); bf16_t* VA = (bf16_t*)(a.ws + WS_VA);
    bf16_t* WBUF = (bf16_t*)(a.ws + WS_WBUF); bf16_t* ATT = (bf16_t*)(a.ws + WS_ATT); const bf16_t* HALO = (const bf16_t*)(a.ws + WS_HALO);
    const float* BD = (const float*)(a.ws + WS_BD); float* GL = (float*)(a.ws + WS_GL);
    unsigned praw[3][11]; f32x2 pcw[3][4]; float pbd[2];
#define P2_FETCH(it_) do { const int tl_ = threadIdx.x, ln_ = tl_ & 63, wv_ = tl_ >> 6; const int bh_ = (it_) / NCH, n_ = (it_) - bh_ * NCH, b_ = bh_ >> 3, h_ = bh_ & 7; \
        const int rb_ = b_ * LP + 64 * n_, gc_ = b_ * NCH + n_, col_ = h_ * 128 + 2 * ln_, r0_ = wv_ * 8; \
        _Pragma("unroll") for (int seg = 0; seg < 3; ++seg) { const bf16_t* src_ = seg == 0 ? QA : (seg == 1 ? KA : VA); \
            _Pragma("unroll") for (int t = 0; t < 11; ++t) { const int ri = r0_ - 3 + t; unsigned w_; \
                if (ri >= 0) w_ = *(const unsigned*)(src_ + (size_t)(rb_ + ri) * 1024 + col_); \
                else w_ = n_ > 0 ? *(const unsigned*)(HALO + ((size_t)(gc_ - 1) * 3 + t) * 3072 + seg * 1024 + col_) : 0u; \
                praw[seg][t] = w_; } \
            _Pragma("unroll") for (int j = 0; j < 4; ++j) pcw[seg][j] = *(const f32x2*)(a.conv_w + (size_t)j * 3072 + seg * 1024 + col_); } \
        pbd[0] = BD[(size_t)(rb_ + ln_) * 16 + h_]; pbd[1] = BD[(size_t)(rb_ + ln_) * 16 + 8 + h_]; } while (0)
    if (bid < 64 * NCH) P2_FETCH(bid);
    for (int item = bid; item < 64 * NCH; item += G) {
        int tid_ = threadIdx.x; asm volatile("" : "+v"(tid_));
        const int tid = tid_, lane = tid & 63, wave = tid >> 6, fr = lane & 15, fq = lane >> 4;
        int z; asm volatile("s_mov_b32 %0, 0" : "=s"(z));
        LAS unsigned char* ldz = lds + z;
        LAS bf16_t* Qs = (LAS bf16_t*)(ldz + P2_QS); LAS bf16_t* Ks = (LAS bf16_t*)(ldz + P2_KS); LAS float* Vs = (LAS float*)(ldz + P2_VS);
        LAS float* Am = (LAS float*)(ldz + P2_AM); LAS bf16_t* Xo = (LAS bf16_t*)(ldz + P2_XO);
        LAS float* GC = (LAS float*)(ldz + P2_GC); LAS float* BETA = (LAS float*)(ldz + P2_BETA); LAS float* EGC = (LAS float*)(ldz + P2_EGC);
        LAS float* RX = (LAS float*)(ldz + P2_VS); LAS float* SCL = (LAS float*)(ldz + P2_SCL); LAS float* UPD = (LAS float*)(ldz + P2_QS);
        const int bh = item / NCH, n = item - bh * NCH, b = bh >> 3, h = bh & 7;
        const int rowbase = b * LP + 64 * n, gchunk = b * NCH + n;
        {
            const int r0 = wave * 8;
#pragma unroll
            for (int seg = 0; seg < 3; ++seg) {
                float x0[11], x1[11];
#pragma unroll
                for (int t = 0; t < 11; ++t) { x0[t] = bf_lo(praw[seg][t]); x1[t] = bf_hi(praw[seg][t]); }
#pragma unroll
                for (int rr = 0; rr < 8; ++rr) {
                    float y0 = 0.f, y1 = 0.f;
#pragma unroll
                    for (int j = 0; j < 4; ++j) { y0 += pcw[seg][j][0] * x0[rr + j]; y1 += pcw[seg][j][1] * x1[rr + j]; }
                    y0 = siluf_(y0); y1 = siluf_(y1);
                    const int r = r0 + rr;
                    if (seg < 2) {
                        const float ss = wave_sum_dpp(y0 * y0 + y1 * y1);
                        const float sc = rsqrtf(ss + 1e-6f) * (seg == 0 ? 0.08838834764831845f : 1.f);
                        *(LAS unsigned*)((seg == 0 ? Qs : Ks) + r * 136 + 2 * lane) = cvt_pk_bf16(y0 * sc, y1 * sc);
                        if (seg == 1) *(LAS f32x2*)(RX + r * 264 + 128 + 2 * lane) = (f32x2){y0 * sc, y1 * sc};
                    } else { *(LAS f32x2*)(RX + r * 264 + 2 * lane) = (f32x2){y0, y1}; }
                }
            }
            if (wave == 7) {
                const float braw = pbd[0], araw = pbd[1];
                const float xx = araw + a.dt_bias[h];
                const float sp = xx > 20.f ? xx : log1pf(__expf(xx));
                float g = -__expf(a.a_log[h]) * sp;
                if (n == 0 && lane < 48) g = 0.f;
#pragma unroll
                for (int o = 1; o < 64; o <<= 1) { const float t = __shfl_up(g, o); if (lane >= o) g += t; }
                const float be = sigmoidf_(braw), eg = __expf(g);
                GC[lane] = g; BETA[lane] = be; EGC[lane] = eg; SCL[lane] = be; SCL[64 + lane] = be * eg;
            }
            { const int nit = item + G < 64 * NCH ? item + G : item; P2_FETCH(nit); }
        }
        __syncthreads();
        {
            const int mi = wave >> 1;
            bf16x8 kA[4], qA[4];
#pragma unroll
            for (int kk = 0; kk < 4; ++kk) { kA[kk] = *(const LAS bf16x8*)(Ks + (16 * mi + fr) * 136 + 32 * kk + 8 * fq); qA[kk] = *(const LAS bf16x8*)(Qs + (16 * mi + fr) * 136 + 32 * kk + 8 * fq); }
            const int i = 16 * mi + fr; const float gci = GC[i], bi = BETA[i];
#pragma unroll
            for (int jj = 0; jj < 2; ++jj) {
                const int nj = (wave & 1) * 2 + jj;
                bf16_t* ap = ATT + (size_t)item * 4096 + i * 64 + 16 * nj + 4 * fq;
                if (nj > mi) { *(u32x2*)ap = (u32x2){0u, 0u}; continue; }
                f32x4 ck = {0.f, 0.f, 0.f, 0.f}, cq = {0.f, 0.f, 0.f, 0.f};
#pragma unroll
                for (int kk = 0; kk < 4; ++kk) { const bf16x8 kB = *(const LAS bf16x8*)(Ks + (16 * nj + fr) * 136 + 32 * kk + 8 * fq);
                    ck = __builtin_amdgcn_mfma_f32_16x16x32_bf16(kB, kA[kk], ck, 0, 0, 0); cq = __builtin_amdgcn_mfma_f32_16x16x32_bf16(kB, qA[kk], cq, 0, 0, 0); }
                f32x4 am, at;
#pragma unroll
                for (int r = 0; r < 4; ++r) { const int j = 16 * nj + 4 * fq + r; const float d = j <= i ? __expf(gci - GC[j]) : 0.f;
                    am[r] = j < i ? bi * ck[r] * d : 0.f; at[r] = cq[r] * d; }
                *(LAS f32x4*)(Am + i * 68 + 16 * nj + 4 * fq) = am;
                *(u32x2*)ap = (u32x2){cvt_pk_bf16(at[0], at[1]), cvt_pk_bf16(at[2], at[3])};
            }
        }
        __syncthreads();
        {
            const int c = tid & 255; const bool solver = tid < 256;
            unsigned amv; asm volatile("v_mov_b32 %0, %1" : "=v"(amv) : "s"((unsigned)(size_t)Am));
            const LAS float* AmV = (const LAS float*)(size_t)amv;
            const LAS float* rscl = SCL + (c < 128 ? 0 : 64);
            LAS float* RXc = RX + c;
#pragma unroll
            for (int bi = 0; bi < 4; ++bi) {
                if (bi > 0) {
#pragma unroll
                    for (int t2 = 0; t2 < 2; ++t2) { const int ct = 2 * wave + t2; f32x4 acc = {0.f, 0.f, 0.f, 0.f};
#pragma unroll
                        for (int ks = 0; ks < 4 * bi; ++ks) acc = __builtin_amdgcn_mfma_f32_16x16x4f32(Am[(16 * bi + fr) * 68 + 4 * ks + fq], RX[(4 * ks + fq) * 264 + 16 * ct + fr], acc, 0, 0, 0);
#pragma unroll
                        for (int r = 0; r < 4; ++r) UPD[(4 * fq + r) * 260 + 16 * ct + fr] = acc[r]; }
                    __syncthreads();
                }
                if (solver) {
                    float xb[16];
#pragma unroll
                    for (int r = 0; r < 16; ++r) { xb[r] = rscl[16 * bi + r] * RXc[(16 * bi + r) * 264]; if (bi > 0) xb[r] -= UPD[r * 260 + c]; }
#pragma unroll
                    for (int j = 0; j < 15; ++j) {
#pragma unroll
                        for (int r = j + 1; r < 16; ++r) xb[r] -= AmV[(16 * bi + r) * 68 + 16 * bi + j] * xb[j];
                        if ((j & 3) == 3) asm volatile("" ::: "memory");
                    }
#pragma unroll
                    for (int r = 0; r < 16; ++r) RXc[(16 * bi + r) * 264] = xb[r];
                } else if (bi == 0) {
                    const int t = tid - 256;
#pragma unroll
                    for (int e4 = 0; e4 < 4; ++e4) { const int id = t + 256 * e4, i = id >> 4, cc = id & 15; float q[8]; unpack8(*(const LAS u32x4*)(Qs + i * 136 + 8 * cc), q); const float eg = EGC[i];
                        u32x4 w; w.x = cvt_pk_bf16(q[0] * eg, q[1] * eg); w.y = cvt_pk_bf16(q[2] * eg, q[3] * eg); w.z = cvt_pk_bf16(q[4] * eg, q[5] * eg); w.w = cvt_pk_bf16(q[6] * eg, q[7] * eg);
                        *(u32x4*)(QA + (size_t)(rowbase + i) * 1024 + h * 128 + 8 * cc) = w; }
                    const float gl = GC[63];
#pragma unroll
                    for (int e4 = 0; e4 < 4; ++e4) { const int id = t + 256 * e4, dk = id >> 3, ib = id & 7; float kv[8];
#pragma unroll
                        for (int e = 0; e < 8; ++e) { const int i = 8 * ib + e; kv[e] = bf2f(Ks[i * 136 + dk]) * __expf(gl - GC[i]); }
                        u32x4 w; w.x = cvt_pk_bf16(kv[0], kv[1]); w.y = cvt_pk_bf16(kv[2], kv[3]); w.z = cvt_pk_bf16(kv[4], kv[5]); w.w = cvt_pk_bf16(kv[6], kv[7]);
                        *(u32x4*)(KA + (size_t)(rowbase + (dk >> 1)) * 1024 + h * 128 + (dk & 1) * 64 + 8 * ib) = w; }
                    if (t == 0) GL[item] = __expf(gl);
                }
                if (bi < 3) __syncthreads();
            }
            if (solver) {
                if (c < 128) {
                    const int s32 = c & ~31, dvl = c & 31;
#pragma unroll
                    for (int q = 0; q < 8; ++q) { float x8[8];
#pragma unroll
                        for (int e = 0; e < 8; ++e) x8[e] = RXc[(8 * q + e) * 264];
                        u32x4 w; w.x = cvt_pk_bf16(x8[0], x8[1]); w.y = cvt_pk_bf16(x8[2], x8[3]); w.z = cvt_pk_bf16(x8[4], x8[5]); w.w = cvt_pk_bf16(x8[6], x8[7]);
                        *(u32x4*)(VA + (size_t)(rowbase + 2 * dvl + (q >> 2)) * 1024 + h * 128 + s32 + (q & 3) * 8) = w; }
                } else {
                    const int dk = c - 128;
#pragma unroll
                    for (int i = 0; i < 64; i += 2) { const unsigned w = cvt_pk_bf16(RXc[i * 264], RXc[(i + 1) * 264]); Xo[i * 136 + dk] = (bf16_t)(w & 0xffffu); Xo[(i + 1) * 136 + dk] = (bf16_t)(w >> 16); }
                }
            }
        }
        __syncthreads();
#pragma unroll
        for (int e2 = 0; e2 < 2; ++e2) { const int id = tid + 512 * e2, i = id >> 4, cc = id & 15;
            *(u32x4*)(WBUF + (size_t)(rowbase + i) * 1024 + h * 128 + 8 * cc) = *(const LAS u32x4*)(Xo + i * 136 + 8 * cc); }
        __syncthreads();
    }
#undef P2_FETCH
}

constexpr int SC_ST = 0, SC_VT = 8704, SC_W = 13312, SC_Q = 30720, SC_K = 48128, SC_A = 66560, SC_U = 75776;
__device__ __forceinline__ void scan_item(const Args& a, LAS unsigned char* lds, int sid) {
    int tid_ = threadIdx.x; asm volatile("" : "+v"(tid_));
    const int tid = tid_, lane = tid & 63, wave = tid >> 6, fr = lane & 15, fq = lane >> 4;
    const int bh = (sid & 7) * 8 + (sid >> 5), s = (sid >> 3) & 3, b = bh >> 3, h = bh & 7;
    const bf16_t* QA = (const bf16_t*)(a.ws + WS_QA); const bf16_t* KA = (const bf16_t*)(a.ws + WS_KA); bf16_t* VA = (bf16_t*)(a.ws + WS_VA);
    const bf16_t* WBUF = (const bf16_t*)(a.ws + WS_WBUF); const bf16_t* ATT = (const bf16_t*)(a.ws + WS_ATT);
    const float* GL = (const float*)(a.ws + WS_GL); float* SSQ = (float*)(a.ws + WS_SSQ);
    LAS bf16_t* ST = (LAS bf16_t*)(lds + SC_ST);
    LAS bf16_t* VT = (LAS bf16_t*)(lds + SC_VT);
    const int mt = wave >> 1, nt = wave & 1, colh = h * 128;
    const int dvl = 16 * nt + fr, i0 = 16 * mt + 4 * fq;
    const int srow = tid >> 4, scc = tid & 15;
    const unsigned dW0 = SC_W + srow * 272 + scc * 16, dW1 = dW0 + 32 * 272, dQ0 = dW0 + (SC_Q - SC_W), dQ1 = dQ0 + 32 * 272;
    const unsigned dK0 = SC_K + (2 * srow + (scc >> 3)) * 144 + (scc & 7) * 16, dK1 = dK0 + 64 * 144;
    const unsigned dA = SC_A + (tid >> 3) * 144 + (tid & 7) * 16;
    const int urow = (tid & 255) >> 2, uc4 = tid & 3;
    const unsigned dU = SC_U + (urow >> 1) * 144 + (32 * (urow & 1) + 8 * uc4) * 2;
    u32x4 Ra[8], Rb[8];
#define SC_LOAD(R, n_) do { const int rb_ = b * LP + 64 * (n_); const size_t o0_ = (size_t)(rb_ + srow) * 1024 + colh + 8 * scc, o1_ = o0_ + 32 * 1024; \
        R[0] = *(const u32x4*)(WBUF + o0_); R[1] = *(const u32x4*)(WBUF + o1_); R[2] = *(const u32x4*)(QA + o0_); R[3] = *(const u32x4*)(QA + o1_); \
        R[4] = *(const u32x4*)(KA + o0_); R[5] = *(const u32x4*)(KA + o1_); R[6] = *(const u32x4*)(ATT + (size_t)(bh * NCH + (n_)) * 4096 + 8 * tid); \
        R[7] = *(const u32x4*)(VA + (size_t)(rb_ + urow) * 1024 + colh + 32 * s + 8 * uc4); } while (0)
#define SC_PARK(R) do { *(LAS u32x4*)(lds + dW0) = R[0]; *(LAS u32x4*)(lds + dW1) = R[1]; *(LAS u32x4*)(lds + dQ0) = R[2]; *(LAS u32x4*)(lds + dQ1) = R[3]; \
        *(LAS u32x4*)(lds + dK0) = R[4]; *(LAS u32x4*)(lds + dK1) = R[5]; *(LAS u32x4*)(lds + dA) = R[6]; if (tid < 256) *(LAS u32x4*)(lds + dU) = R[7]; } while (0)
    bf16x8 wA[4], qA[4], aA[2], kA[2]; u32x2 uw;
#define SC_FRAGS() do { \
        _Pragma("unroll") for (int kk = 0; kk < 4; ++kk) { wA[kk] = *(const LAS bf16x8*)(lds + SC_W + (16 * mt + fr) * 272 + (32 * kk + 8 * fq) * 2); qA[kk] = *(const LAS bf16x8*)(lds + SC_Q + (16 * mt + fr) * 272 + (32 * kk + 8 * fq) * 2); } \
        _Pragma("unroll") for (int kk = 0; kk < 2; ++kk) { aA[kk] = *(const LAS bf16x8*)(lds + SC_A + (16 * mt + fr) * 144 + (32 * kk + 8 * fq) * 2); kA[kk] = *(const LAS bf16x8*)(lds + SC_K + (16 * wave + fr) * 144 + (32 * kk + 8 * fq) * 2); } \
        uw = *(const LAS u32x2*)(lds + SC_U + dvl * 144 + i0 * 2); } while (0)
    for (int i = tid; i < 32 * 136 / 2; i += 512) ((LAS unsigned*)ST)[i] = 0u;
    f32x4 Sacc[2] = {{0.f, 0.f, 0.f, 0.f}, {0.f, 0.f, 0.f, 0.f}};
    SC_LOAD(Ra, 0); SC_PARK(Ra);
    __syncthreads();
    SC_FRAGS();
    float gl = GL[bh * NCH];
    __syncthreads();
    SC_LOAD(Ra, 1); SC_PARK(Ra);
    SC_LOAD(Ra, 2);
    for (int n = 0; n < NCH; ++n) {
        const int rowbase = b * LP + 64 * n;
        { const int nn = n + 3 < NCH ? n + 3 : NCH - 1; SC_LOAD(Rb, nn); }
        const float gN = GL[bh * NCH + (n + 1 < NCH ? n + 1 : n)];
        f32x4 a1 = {0.f, 0.f, 0.f, 0.f}, a2 = {0.f, 0.f, 0.f, 0.f};
#pragma unroll
        for (int kk = 0; kk < 4; ++kk) { const bf16x8 sf = *(const LAS bf16x8*)(ST + (16 * nt + fr) * 136 + 32 * kk + 8 * fq);
            a1 = __builtin_amdgcn_mfma_f32_16x16x32_bf16(wA[kk], sf, a1, 0, 0, 0); a2 = __builtin_amdgcn_mfma_f32_16x16x32_bf16(sf, qA[kk], a2, 0, 0, 0); }
        { const float v0 = bf_lo(uw.x) - a1[0], v1 = bf_hi(uw.x) - a1[1], v2 = bf_lo(uw.y) - a1[2], v3 = bf_hi(uw.y) - a1[3];
          *(LAS u32x2*)(VT + (16 * nt + fr) * 72 + 16 * mt + 4 * fq) = (u32x2){cvt_pk_bf16(v0, v1), cvt_pk_bf16(v2, v3)}; }
        __syncthreads();
#pragma unroll
        for (int kk = 0; kk < 2; ++kk) { const bf16x8 vf = *(const LAS bf16x8*)(VT + (16 * nt + fr) * 72 + 32 * kk + 8 * fq);
            a2 = __builtin_amdgcn_mfma_f32_16x16x32_bf16(vf, aA[kk], a2, 0, 0, 0); }
        { const int row = rowbase + 16 * mt + fr;
          *(u32x2*)(VA + (size_t)row * 1024 + colh + 32 * s + 16 * nt + 4 * fq) = (u32x2){cvt_pk_bf16(a2[0], a2[1]), cvt_pk_bf16(a2[2], a2[3])};
          float p = a2[0] * a2[0] + a2[1] * a2[1] + a2[2] * a2[2] + a2[3] * a2[3]; p += __shfl_xor(p, 16); p += __shfl_xor(p, 32);
          if (fq == 0) SSQ[((size_t)row * 8 + h) * 8 + s * 2 + nt] = p; }
#pragma unroll
        for (int n3 = 0; n3 < 2; ++n3) { Sacc[n3] = Sacc[n3] * gl;
#pragma unroll
            for (int kk = 0; kk < 2; ++kk) { const bf16x8 vf = *(const LAS bf16x8*)(VT + (16 * n3 + fr) * 72 + 32 * kk + 8 * fq);
                Sacc[n3] = __builtin_amdgcn_mfma_f32_16x16x32_bf16(kA[kk], vf, Sacc[n3], 0, 0, 0); }
            *(LAS u32x2*)(ST + (16 * n3 + fr) * 136 + 16 * wave + 4 * fq) = (u32x2){cvt_pk_bf16(Sacc[n3][0], Sacc[n3][1]), cvt_pk_bf16(Sacc[n3][2], Sacc[n3][3])}; }
        SC_FRAGS();
        gl = gN;
        __syncthreads();
        SC_PARK(Ra);
#pragma unroll
        for (int e = 0; e < 8; ++e) Ra[e] = Rb[e];
    }
    __syncthreads();
#undef SC_LOAD
#undef SC_PARK
#undef SC_FRAGS
}

__device__ __forceinline__ void swa_items(const Args& a, LAS unsigned char* lds, int bid, int G) {
    int tid = threadIdx.x, lane = tid & 63, wave = tid >> 6, fr = lane & 15, fq = lane >> 4;
    bf16_t* QB = (bf16_t*)(a.ws + WS_QB); const bf16_t* KVB = (const bf16_t*)(a.ws + WS_KVB);
    LAS bf16_t* KL = (LAS bf16_t*)lds;
    LAS bf16_t* VTL = (LAS bf16_t*)(lds + 29952);
    u32x4 kreg[4], vreg[4]; bf16x8 qf[2][2];
#define SWA_FETCH(idx_) do { const int b_ = (idx_) >> 7, rem_ = (idx_) & 127, n_ = 1 + (rem_ >> 2), kvh_ = rem_ & 3; \
        _Pragma("unroll") for (int e = 0; e < 4; ++e) { const int id = tid + 512 * e; kreg[e] = (u32x4){0u, 0u, 0u, 0u}; vreg[e] = (u32x4){0u, 0u, 0u, 0u}; \
            if (id < 208 * 8) { const int key = id >> 3, cc = id & 7; int row; bool valid = true; \
                if (key < 16) row = b_ * LP + 48 + key; else { const int jj = (key - 16) >> 6, c = (key - 16) & 63, j = n_ - 2 + jj; valid = j >= 1; row = b_ * LP + 64 * (j < 0 ? 0 : j) + c; } \
                if (valid) { kreg[e] = *(const u32x4*)(KVB + (size_t)row * 512 + kvh_ * 64 + 8 * cc); vreg[e] = *(const u32x4*)(KVB + (size_t)row * 512 + 256 + kvh_ * 64 + 8 * cc); } } } \
        { const int g_ = wave >> 1, half_ = wave & 1, head_ = kvh_ * 4 + g_, rb_ = b_ * LP + 64 * n_; \
          _Pragma("unroll") for (int mt = 0; mt < 2; ++mt) _Pragma("unroll") for (int kk = 0; kk < 2; ++kk) \
              qf[mt][kk] = *(const bf16x8*)(QB + (size_t)(rb_ + 32 * half_ + 16 * mt + fr) * 1024 + head_ * 64 + 32 * kk + 8 * fq); } } while (0)
    if (bid < 1024) SWA_FETCH(bid);
  for (int idx = bid; idx < 1024; idx += G) {
    tid = threadIdx.x; asm volatile("" : "+v"(tid)); lane = tid & 63; wave = tid >> 6; fr = lane & 15; fq = lane >> 4;
    const int b = idx >> 7, rem = idx & 127, n = 1 + (rem >> 2), kvh = rem & 3;
    const int rowbase = b * LP + 64 * n;
#pragma unroll
    for (int e = 0; e < 4; ++e) { const int id = tid + 512 * e;
        if (id < 208 * 8) { const int key = id >> 3, cc = id & 7; const u32x4 kw = kreg[e], vw = vreg[e];
            *(LAS u32x4*)(KL + key * 72 + 8 * cc) = kw;
            LAS bf16_t* vp = VTL + (8 * cc) * 232 + key;
            vp[0 * 232] = (bf16_t)(vw.x & 0xffffu); vp[1 * 232] = (bf16_t)(vw.x >> 16); vp[2 * 232] = (bf16_t)(vw.y & 0xffffu); vp[3 * 232] = (bf16_t)(vw.y >> 16);
            vp[4 * 232] = (bf16_t)(vw.z & 0xffffu); vp[5 * 232] = (bf16_t)(vw.z >> 16); vp[6 * 232] = (bf16_t)(vw.w & 0xffffu); vp[7 * 232] = (bf16_t)(vw.w >> 16); } }
    if (tid < 128) { const int r = tid >> 1, hh = tid & 1; *(LAS u32x4*)(VTL + r * 232 + 208 + 8 * hh) = (u32x4){0u, 0u, 0u, 0u}; }
    __syncthreads();
    {
        const int g = wave >> 1, half = wave & 1, head = kvh * 4 + g;
        const float slope2 = exp2f(-0.5f * (float)(head + 1)) * LOG2E, sink2 = a.sinks[head] * LOG2E;
        f32x4 sc[2][13];
#pragma unroll
        for (int kt = 0; kt < 13; ++kt) {
            const bf16x8 k0 = *(const LAS bf16x8*)(KL + (16 * kt + fr) * 72 + 8 * fq), k1 = *(const LAS bf16x8*)(KL + (16 * kt + fr) * 72 + 32 + 8 * fq);
#pragma unroll
            for (int mt = 0; mt < 2; ++mt) { f32x4 c = {0.f, 0.f, 0.f, 0.f};
                c = __builtin_amdgcn_mfma_f32_16x16x32_bf16(k0, qf[mt][0], c, 0, 0, 0); c = __builtin_amdgcn_mfma_f32_16x16x32_bf16(k1, qf[mt][1], c, 0, 0, 0); sc[mt][kt] = c; }
        }
        float mx[2], sm[2];
#pragma unroll
        for (int mt = 0; mt < 2; ++mt) {
            const int tq = 64 * n + 32 * half + 16 * mt + fr - 48;
            float m = sink2;
#pragma unroll
            for (int kt = 0; kt < 13; ++kt)
#pragma unroll
                for (int r = 0; r < 4; ++r) { const int sidx = 16 * kt + 4 * fq + r; int tk; bool valid = true;
                    if (kt == 0) tk = sidx; else { const int jj = (sidx - 16) >> 6, j = n - 2 + jj; valid = j >= 1; tk = 64 * j + ((sidx - 16) & 63) - 48; }
                    const int dd = tq - tk; const float dist = (float)(dd < 0 ? -dd : dd);
                    const float v = valid ? sc[mt][kt][r] * (0.125f * LOG2E) - slope2 * dist : -1e30f;
                    sc[mt][kt][r] = v; m = fmaxf(m, v); }
            m = fmaxf(m, __shfl_xor(m, 16)); m = fmaxf(m, __shfl_xor(m, 32));
            float ssum = 0.f;
#pragma unroll
            for (int kt = 0; kt < 13; ++kt)
#pragma unroll
                for (int r = 0; r < 4; ++r) { const float p = exp2f(sc[mt][kt][r] - m); sc[mt][kt][r] = p; ssum += p; }
            ssum += __shfl_xor(ssum, 16); ssum += __shfl_xor(ssum, 32);
            mx[mt] = m; sm[mt] = ssum + exp2f(sink2 - m);
        }
        f32x4 oacc[2][4];
#pragma unroll
        for (int mt = 0; mt < 2; ++mt)
#pragma unroll
            for (int nt = 0; nt < 4; ++nt) oacc[mt][nt] = (f32x4){0.f, 0.f, 0.f, 0.f};
#pragma unroll
        for (int kk = 0; kk < 7; ++kk) {
            bf16x8 pf[2];
#pragma unroll
            for (int mt = 0; mt < 2; ++mt) { u32x4 w; w.x = cvt_pk_bf16(sc[mt][2 * kk][0], sc[mt][2 * kk][1]); w.y = cvt_pk_bf16(sc[mt][2 * kk][2], sc[mt][2 * kk][3]);
                if (kk < 6) { w.z = cvt_pk_bf16(sc[mt][2 * kk + 1 < 13 ? 2 * kk + 1 : 12][0], sc[mt][2 * kk + 1 < 13 ? 2 * kk + 1 : 12][1]); w.w = cvt_pk_bf16(sc[mt][2 * kk + 1 < 13 ? 2 * kk + 1 : 12][2], sc[mt][2 * kk + 1 < 13 ? 2 * kk + 1 : 12][3]); }
                else { w.z = 0u; w.w = 0u; }
                pf[mt] = __builtin_bit_cast(bf16x8, w); }
#pragma unroll
            for (int nt = 0; nt < 4; ++nt) {
                const u32x2 v0 = *(const LAS u32x2*)(VTL + (16 * nt + fr) * 232 + 32 * kk + 4 * fq), v1 = *(const LAS u32x2*)(VTL + (16 * nt + fr) * 232 + 32 * kk + 16 + 4 * fq);
                const bf16x8 vf = __builtin_bit_cast(bf16x8, ((u32x4){v0.x, v0.y, v1.x, v1.y}));
#pragma unroll
                for (int mt = 0; mt < 2; ++mt) oacc[mt][nt] = __builtin_amdgcn_mfma_f32_16x16x32_bf16(vf, pf[mt], oacc[mt][nt], 0, 0, 0);
            }
        }
        { const int nidx = idx + G < 1024 ? idx + G : idx; SWA_FETCH(nidx); }
#pragma unroll
        for (int mt = 0; mt < 2; ++mt) { const float inv = 1.f / sm[mt]; (void)mx;
#pragma unroll
            for (int nt = 0; nt < 4; ++nt) { const f32x4 o = oacc[mt][nt] * inv;
                *(u32x2*)(QB + (size_t)(rowbase + 32 * half + 16 * mt + fr) * 1024 + head * 64 + 16 * nt + 4 * fq) = (u32x2){cvt_pk_bf16(o[0], o[1]), cvt_pk_bf16(o[2], o[3])}; } }
    }
    __syncthreads();
  }
#undef SWA_FETCH
}

__device__ __forceinline__ void phase6(const Args& a, int bid, int G) {
    const int tid = threadIdx.x, lane = tid & 63, wave = tid >> 6;
    const int gw = bid * 8 + wave, NGW = G * 8;
    f32x4 lw[4], lb[4];
#pragma unroll
    for (int j = 0; j < 4; ++j) { lw[j] = ((const f32x4*)a.ln_w)[lane + 64 * j]; lb[j] = ((const f32x4*)a.ln_b)[lane + 64 * j]; }
    for (int row = gw; row < MR; row += NGW) {
        f32x4* p = (f32x4*)(a.out + (size_t)row * 1024) + lane;
        f32x4 v[4]; float s = 0.f;
#pragma unroll
        for (int j = 0; j < 4; ++j) { v[j] = p[64 * j]; s += (v[j][0] + v[j][1]) + (v[j][2] + v[j][3]); }
        const float mean = wave_sum(s) * (1.f / 1024.f); float s2 = 0.f;
#pragma unroll
        for (int j = 0; j < 4; ++j) { v[j] = v[j] - mean; s2 += (v[j][0] * v[j][0] + v[j][1] * v[j][1]) + (v[j][2] * v[j][2] + v[j][3] * v[j][3]); }
        const float rstd = rsqrtf(wave_sum(s2) * (1.f / 1024.f) + 1e-5f);
#pragma unroll
        for (int j = 0; j < 4; ++j) p[64 * j] = v[j] * rstd * lw[j] + lb[j];
    }
}

#define XB_TMO      128
#define XB_XCNT(j)  (256  + 64 * (j))
#define XB_XSUB(j)  (1280 + 64 * (j))
#define XB_XGEN(j)  (2304 + 64 * (j))
#define XB_TOP      3328
#define XB_TOPGEN   3392
#define XCD_BAR_WORDS 3456
#define XB_SPIN_CAP (1u << 22)
__device__ __forceinline__ unsigned xb_ld(unsigned* p)              { return __hip_atomic_load(p, __ATOMIC_RELAXED, __HIP_MEMORY_SCOPE_AGENT); }
__device__ __forceinline__ unsigned xb_add(unsigned* p, unsigned v) { return __hip_atomic_fetch_add(p, v, __ATOMIC_RELAXED, __HIP_MEMORY_SCOPE_AGENT); }
__device__ __forceinline__ unsigned xb_xcc_id() { return (unsigned)__builtin_amdgcn_s_getreg((3 << 11) | 20) & 0xFu; }
#define XB_SPIN(cond, bar) do { unsigned _sp = 0; while (cond) { __builtin_amdgcn_s_sleep(1); \
    if ((++_sp & 255u) == 0u) { if (xb_ld(&(bar)[XB_TMO])) break; if (_sp > XB_SPIN_CAP) { atomicAdd(&(bar)[XB_TMO], 1u); break; } } } } while (0)
struct XcdBarrier { unsigned* bar; unsigned x; volatile LAS unsigned* st; };
__device__ __forceinline__ XcdBarrier xcd_barrier_post(unsigned* bar, volatile LAS unsigned* st) {
    XcdBarrier b; b.bar = bar; b.x = xb_xcc_id(); b.st = st;
    if (threadIdx.x == 0) (void)xb_add(&bar[XB_XCNT(b.x)], 1u);
    return b;
}
__device__ __forceinline__ void xcd_barrier_complete(unsigned* bar, unsigned x, unsigned& nloc, unsigned& nx) {
    const unsigned G = gridDim.x * gridDim.y * gridDim.z;
    unsigned sum, cnt, mine, sp = 0u;
    for (;;) {
        sum = 0u; cnt = 0u; mine = 0u;
#pragma unroll
        for (unsigned j = 0; j < 16; ++j) { const unsigned c = xb_ld(&bar[XB_XCNT(j)]); sum += c; cnt += (c > 0u) ? 1u : 0u; mine = (j == x) ? c : mine; }
        if (sum == G) break;
        __builtin_amdgcn_s_sleep(1);
        if ((++sp & 255u) == 0u) { if (xb_ld(&bar[XB_TMO])) break; if (sp > XB_SPIN_CAP) { atomicAdd(&bar[XB_TMO], 1u); break; } }
    }
    nloc = mine > 0u ? mine : 1u; nx = cnt > 0u ? cnt : 1u;
}
__device__ __forceinline__ void xcd_barrier(const XcdBarrier& b) {
    asm volatile("s_waitcnt vmcnt(0)" ::: "memory");
    __syncthreads();
    if (threadIdx.x == 0) {
        unsigned* bar = b.bar;
        __builtin_amdgcn_s_waitcnt(0);
        unsigned nloc = b.st[0], nx = b.st[1];
        if (nloc == 0u) { xcd_barrier_complete(bar, b.x, nloc, nx); b.st[0] = nloc; b.st[1] = nx; }
        const unsigned old = xb_add(&bar[XB_XSUB(b.x)], 1u);
        const unsigned gen = old / nloc;
        if (old + 1u == (gen + 1u) * nloc) {
            __builtin_amdgcn_fence(__ATOMIC_RELEASE, "agent");
            asm volatile("s_waitcnt vmcnt(0)" ::: "memory");
            const unsigned og = xb_add(&bar[XB_TOP], 1u);
            const unsigned tg = og / nx;
            if (og + 1u == (tg + 1u) * nx) xb_add(&bar[XB_TOPGEN], 1u);
            else XB_SPIN(xb_ld(&bar[XB_TOPGEN]) == tg, bar);
            __builtin_amdgcn_fence(__ATOMIC_ACQUIRE, "agent");
            xb_add(&bar[XB_XGEN(b.x)], 1u);
            asm volatile("s_waitcnt vmcnt(0)" ::: "memory");
        } else {
            XB_SPIN(xb_ld(&bar[XB_XGEN(b.x)]) == gen, bar);
            __builtin_amdgcn_fence(__ATOMIC_ACQUIRE, "agent");
            asm volatile("s_waitcnt vmcnt(0)" ::: "memory");
        }
    }
    __syncthreads();
}
__global__ void __launch_bounds__(512, 2) hybrid_fwd(Args a) {
    extern __shared__ __attribute__((aligned(16))) unsigned char lds_raw[];
    LAS unsigned char* lds = (LAS unsigned char*)lds_raw;
    cg::grid_group grid = cg::this_grid();
    const int G = gridDim.x, bid = blockIdx.x;
    volatile LAS unsigned* bst = (volatile LAS unsigned*)(lds + LDS_BYTES - 64);
    if (threadIdx.x < 16) bst[threadIdx.x] = 0u;
    __syncthreads();
    XcdBarrier bar = xcd_barrier_post((unsigned*)(a.ws + WS_CTL), bst);
    grid.sync();
    bf16_t* HB = (bf16_t*)a.out;
    bf16_t* QA = (bf16_t*)(a.ws + WS_QA); bf16_t* KA = (bf16_t*)(a.ws + WS_KA); bf16_t* VA = (bf16_t*)(a.ws + WS_VA); bf16_t* QB = (bf16_t*)(a.ws + WS_QB);
    bf16_t* KVB = (bf16_t*)(a.ws + WS_KVB); bf16_t* WBUF = (bf16_t*)(a.ws + WS_WBUF);

#ifndef ONLY
#define ONLY -1
#endif
#define PH(k) (ONLY < 0 || ONLY == (k))
    if (PH(0)) phase0(a, lds, bid, G);
    xcd_barrier(bar);
    if (PH(1)) {
        pg8::Gemm g{HB, (const bf16_t*)(a.ws + WS_WT1), MP, 4608, 1024, 0, HB, 1024, 16}; pg8::StaticOrder S; S.init(MP, 4608, G, bid);
        EpiP1 E{QA, KA, VA, QB, KVB, (bf16_t*)(a.ws + WS_HALO), a.ws};
        pg8::gemm_phase<EpiP1, true>(lds, g, S, E);
    }
    xcd_barrier(bar);
    if (PH(2)) phase2a(a, lds, bid, G);
    xcd_barrier(bar);
    if (PH(3)) for (int sid = bid; sid < 256; sid += G) scan_item(a, lds, sid);
    if (PH(4)) swa_items(a, lds, bid, G);
    xcd_barrier(bar);
#ifdef DIAG
    {
        const bf16_t* B0 = (const bf16_t*)(a.ws + (DIAG == 1 ? WS_VA : DIAG == 2 ? WS_QB : DIAG == 3 ? WS_QA : DIAG == 4 ? WS_KA : DIAG == 5 ? WS_WBUF : WS_VA));
        for (size_t i = (size_t)bid * 512 + threadIdx.x; i < (size_t)MR * 1024; i += (size_t)G * 512) { const int R = (int)(i >> 10), c = (int)(i & 1023); float v = bf2f(B0[(size_t)real2pad(R) * 1024 + c]);
            if (DIAG == 6) { v = bf2f(((const bf16_t*)(a.ws + WS_QA))[(size_t)real2pad(R) * 1024 + c]) + 2.f * bf2f(((const bf16_t*)(a.ws + WS_KA))[(size_t)real2pad(R) * 1024 + c]);
                if (i < (size_t)2112 * 4096) v += 4.f * bf2f(((const bf16_t*)(a.ws + WS_ATT))[i]); if (i < 2112) v += ((const float*)(a.ws + WS_GL))[i]; }
            a.out[i] = v; }
        return;
    }
#endif
    if (PH(5)) {
        pg8::Gemm g{HB, (const bf16_t*)(a.ws + WS_WT2), MR, 4096, 1024, 1, HB, 1024, 16}; pg8::StaticOrder S; S.init(MR, 4096, G, bid);
        EpiP3 E{VA, QB, QA, KA, (const float*)(a.ws + WS_SSQ), a.gdn_norm_w, a.b_gate, a.ws};
        pg8::gemm_phase<EpiP3, true>(lds, g, S, E);
    }
    xcd_barrier(bar);
    if (PH(6)) {
        pg8::StaticOrder S; S.init(MR, 1024, G, bid);
        pg8::Gemm g{VA, (const bf16_t*)(a.ws + WS_WA), MR, 1024, 2048, 1, QB, 1024, 16};
        EpiP4 E{QA, KA, WBUF, a.ws};
        pg8::gemm_phase<EpiP4, true>(lds, g, S, E);
    }
    xcd_barrier(bar);
    if (PH(7)) {
        pg8::Gemm g{WBUF, (const bf16_t*)(a.ws + WS_WO), MR, 1024, 1024, 0, WBUF, 1024, 16}; pg8::StaticOrder S; S.init(MR, 1024, G, bid);
        EpiP5 E{a.x, a.out};
        pg8::gemm_phase<EpiP5, true>(lds, g, S, E);
    }
    xcd_barrier(bar);
    if (PH(8)) phase6(a, bid, G);
}

extern "C" void kernel_launch(void* const* d_in, const int* in_sizes, int n_in, void* d_out, int out_size, void* d_ws, size_t ws_size, hipStream_t stream) {
    static int grid = 0;
    if (grid == 0) {
        if (n_in != 14 || ws_size < WS_CTL + CTL_BYTES) { fprintf(stderr, "kernel_launch: unexpected inputs (n_in %d, ws %zu)\n", n_in, ws_size); grid = -1; return; }
        int dev = 0, cus = 0, per_cu = 0;
        hipGetDevice(&dev); hipDeviceGetAttribute(&cus, hipDeviceAttributeMultiprocessorCount, dev);
        hipFuncSetAttribute((const void*)hybrid_fwd, hipFuncAttributeMaxDynamicSharedMemorySize, LDS_BYTES);
        hipOccupancyMaxActiveBlocksPerMultiprocessor(&per_cu, (const void*)hybrid_fwd, 512, LDS_BYTES);
        if (per_cu < 1) { fprintf(stderr, "kernel_launch: occupancy query reports %d blocks per CU\n", per_cu); per_cu = 1; }
        grid = cus;
        fprintf(stderr, "kernel_launch: cus %d per_cu %d grid %d\n", cus, per_cu, grid);
    }
    if (grid < 0) return;
    Args a{};
    a.x = (const float*)d_in[0]; a.meta = (const float*)d_in[1]; a.w_in = (const float*)d_in[2]; a.b_gate = (const float*)d_in[3]; a.conv_w = (const float*)d_in[4];
    a.a_log = (const float*)d_in[5]; a.dt_bias = (const float*)d_in[6]; a.gdn_norm_w = (const float*)d_in[7]; a.sinks = (const float*)d_in[8];
    a.w_proj_a = (const float*)d_in[9]; a.w_proj_b = (const float*)d_in[10]; a.w_out = (const float*)d_in[11]; a.ln_w = (const float*)d_in[12]; a.ln_b = (const float*)d_in[13];
    a.out = (float*)d_out; a.ws = (unsigned char*)d_ws;
    if (hipMemsetAsync((char*)d_ws + WS_CTL, 0, CTL_BYTES, stream) != hipSuccess) { fprintf(stderr, "kernel_launch: memset failed\n"); return; }
    void* args[] = {&a};
    hipError_t e = hipLaunchCooperativeKernel((const void*)hybrid_fwd, dim3(grid), dim3(512), args, LDS_BYTES, stream);
    if (e != hipSuccess) fprintf(stderr, "cooperative launch failed: %s (grid %d)\n", hipGetErrorString(e), grid);
}
```

```cpp
#include <hip/hip_runtime.h>
#include <hip/hip_cooperative_groups.h>
#include <cstdio>
#include <cstdint>
namespace cg = cooperative_groups;

#define LAS __attribute__((address_space(3)))
typedef unsigned short bf16_t;
typedef short bf16x8 __attribute__((ext_vector_type(8)));
typedef short bf16x4 __attribute__((ext_vector_type(4)));
typedef float f32x4 __attribute__((ext_vector_type(4)));
typedef float f32x2 __attribute__((ext_vector_type(2)));
typedef unsigned u32x4 __attribute__((ext_vector_type(4)));
typedef unsigned u32x2 __attribute__((ext_vector_type(2)));

constexpr int NB = 8, SEQ = 2048, DM = 1024, LP = 2112, NCH = 33, MP = NB * LP  , MR = NB * SEQ  ;
constexpr int NWIN = 8720;
constexpr float DN_ALPHA = 1.189207115002721f;
constexpr float LOG2E = 1.4426950408889634f;

constexpr size_t SZ_S1 = (size_t)MP * 1024 * 2;
constexpr size_t WS_WT1 = 0;
constexpr size_t WS_WT2 = WS_WT1 + (size_t)4608 * 1024 * 2;
constexpr size_t WS_WA = WS_WT2 + (size_t)4096 * 1024 * 2;
constexpr size_t WS_WB = WS_WA + (size_t)1024 * 1024 * 2;
constexpr size_t WS_WO = WS_WB + (size_t)1024 * 1024 * 2;
constexpr size_t WS_BD = WS_WO + (size_t)1024 * 1024 * 2;
constexpr size_t WS_GL = WS_BD + (size_t)MP * 16 * 4;
constexpr size_t WS_SSQ = WS_GL + 16384;
constexpr size_t WS_HALO = WS_SSQ + (size_t)MP * 64 * 4;
constexpr size_t WS_QA = WS_HALO + (size_t)264 * 3 * 3072 * 2;
constexpr size_t WS_KA = WS_QA + SZ_S1;
constexpr size_t WS_VA = WS_KA + SZ_S1;
constexpr size_t WS_QB = WS_VA + SZ_S1;
constexpr size_t WS_KVB = WS_QB + SZ_S1;
constexpr size_t WS_WBUF = WS_KVB + (size_t)MP * 512 * 2;
constexpr size_t WS_ATT = WS_WBUF + SZ_S1;
constexpr size_t WS_END = WS_ATT + (size_t)2112 * 4096 * 2;
constexpr size_t WS_CTL = WS_END;
constexpr size_t CTL_BYTES = 16384;
static_assert(WS_CTL + CTL_BYTES <= 268435456 && WS_CTL % 256 == 0, "workspace map");

constexpr int LDS_BYTES = 147456;

typedef __bf16 bf16x2_t __attribute__((ext_vector_type(2)));
__device__ __forceinline__ unsigned cvt_pk_bf16(float lo, float hi) { const f32x2 v = {lo, hi}; return __builtin_bit_cast(unsigned, __builtin_convertvector(v, bf16x2_t)); }
__device__ __forceinline__ float bf_lo(unsigned w) { return __uint_as_float(w << 16); }
__device__ __forceinline__ float bf_hi(unsigned w) { return __uint_as_float(w & 0xffff0000u); }
__device__ __forceinline__ float bf2f(bf16_t b) { return __uint_as_float(((unsigned)b) << 16); }
__device__ __forceinline__ float sigmoidf_(float x) { return __builtin_amdgcn_rcpf(1.f + __expf(-x)); }
__device__ __forceinline__ float siluf_(float x) { return x * sigmoidf_(x); }
__device__ __forceinline__ float wave_sum(float v) {
#pragma unroll
    for (int o = 1; o < 64; o <<= 1) v += __shfl_xor(v, o);
    return v;
}
__device__ __forceinline__ float wave_sum_dpp(float v) {
    v += __builtin_bit_cast(float, __builtin_amdgcn_update_dpp(0, __builtin_bit_cast(int, v), 0xB1, 0xF, 0xF, true));
    v += __builtin_bit_cast(float, __builtin_amdgcn_update_dpp(0, __builtin_bit_cast(int, v), 0x4E, 0xF, 0xF, true));
    v += __builtin_bit_cast(float, __builtin_amdgcn_update_dpp(0, __builtin_bit_cast(int, v), 0x141, 0xF, 0xF, true));
    v += __builtin_bit_cast(float, __builtin_amdgcn_update_dpp(0, __builtin_bit_cast(int, v), 0x140, 0xF, 0xF, true));
    const int vi = __builtin_bit_cast(int, v);
    return (__builtin_bit_cast(float, __builtin_amdgcn_readlane(vi, 0)) + __builtin_bit_cast(float, __builtin_amdgcn_readlane(vi, 16)))
         + (__builtin_bit_cast(float, __builtin_amdgcn_readlane(vi, 32)) + __builtin_bit_cast(float, __builtin_amdgcn_readlane(vi, 48)));
}
#define LDS_WAIT() asm volatile("s_waitcnt lgkmcnt(0)" ::: "memory")

namespace pg8 {
constexpr int BM = 256, BK = 64, HALF = 128, HTB = HALF * BK * 2, STAGE_BYTES = 8 * HTB, NXCD = 8, WGM = 8;
__host__ __device__ __forceinline__ int lds_byte(int r, int c) { const int st = (r >> 4) * 2 + (c >> 5), rr = r & 15, cc = c & 31, ob = rr * 64 + cc * 2; return st * 1024 + (ob ^ (((ob >> 9) & 1) << 5)); }
__host__ __device__ __forceinline__ void stage_rc(int b, int& R, int& C) { const int st = b / 1024, sb = b % 1024, swz = sb ^ (((sb >> 9) & 1) << 5); R = (st >> 1) * 16 + swz / 64; C = (st & 1) * 32 + (swz % 64) / 2; }
__host__ __device__ __forceinline__ int perm32(int rho) { const int n = rho >> 4, i = rho & 15; return 8 * (i >> 2) + 4 * n + (i & 3); }
struct Unit { int pm, pn; };
struct Gemm { const bf16_t* A; const bf16_t* Bt; int M, N, K, amode; const bf16_t* A2; int lda, split;
    __device__ __forceinline__ size_t aoffs(int pm) const { const int r = amode ? ((pm >> 3) * LP + 64 + (pm & 7) * 256) : pm * 256; return (size_t)r * lda * 2; } };
struct StaticOrder {
    int nM, nN, nwg, G, c;
    __host__ __device__ void init(int M, int N, int G_, int c_) { nM = M / BM; nN = N / BM; nwg = nM * nN; G = G_; c = c_; }
    __host__ __device__ bool next(int i, Unit& u) const {
        const long L = (long)i * G + c; if (L >= nwg) return false;
        int wgid = (int)L; { const int q = nwg / NXCD, r = nwg % NXCD, xcd = wgid % NXCD, off = wgid / NXCD; wgid = (xcd < r ? xcd * (q + 1) : r * (q + 1) + (xcd - r) * q) + off; }
        const int nig = WGM * nN, gid = wgid / nig, fm = gid * WGM, gsz = (nM - fm) < WGM ? (nM - fm) : WGM;
        u.pm = fm + ((wgid % nig) % gsz); u.pn = (wgid % nig) / gsz; return true;
    }
};
template <class Epi, bool ALIGN_EPI>
__device__ __forceinline__ void gemm_phase(LAS unsigned char* lds, const Gemm g, const StaticOrder& S, const Epi& E) {
    int tid = threadIdx.x; asm volatile("" : "+v"(tid));
    const int wid = __builtin_amdgcn_readfirstlane(tid >> 6), lane = tid & 63, wr = wid >> 2, wc = wid & 3, fr = lane & 15, fq = lane >> 4;
    const int K = g.K, nt = K / BK;
    unsigned voffA[2], voffB[2];
#pragma unroll
    for (int i = 0; i < 2; ++i) { int R, C; stage_rc(tid * 16 + i * 8192, R, C); const int Rb = (R & ~31) + perm32(R & 31);
        voffA[i] = (unsigned)(R * g.lda + C) * 2u; voffB[i] = (unsigned)(Rb * K + C) * 2u; }
    const size_t kstep = (size_t)(BK * 2);
    const size_t hstep = (size_t)HALF * K * 2;
    const size_t hstepA = (size_t)HALF * g.lda * 2;
    const size_t tstep = 2 * hstep;
    const int split = g.split; const ptrdiff_t a2d = ((const char*)g.A2 - (const char*)g.A) - (ptrdiff_t)split * (ptrdiff_t)kstep;
#define PG8_AK(base, t) ((base) + ((t) < split ? (ptrdiff_t)0 : a2d) + (size_t)(t) * kstep)
    const unsigned ldsw = (unsigned)wid * 1024u;
    const int aoff = lds_byte(wr * 64 + fr, fq * 8), boff = lds_byte(wc * 32 + fr, fq * 8);
#define PG8_SA(b, h) (((b) * 2 + (h)) * HTB)
#define PG8_SB(b, h) ((4 + (b) * 2 + (h)) * HTB)
#define PG8_STAGE(bufoff, gbase, voff) do { _Pragma("unroll") for (int _i = 0; _i < 2; ++_i) \
        __builtin_amdgcn_global_load_lds((const unsigned*)((const char*)(gbase) + (voff)[_i]), (LAS unsigned*)(lds + (bufoff) + ldsw + _i * 8192), 16, 0, 0); } while (0)
#define PG8_LDA(dst, b, h) do { _Pragma("unroll") for (int m = 0; m < 4; ++m) _Pragma("unroll") for (int k = 0; k < 2; ++k) dst[m][k] = *(const LAS bf16x8*)(lds + PG8_SA(b, h) + aoff + m * 2048 + k * 1024); } while (0)
#define PG8_LDB(dst, b, h) do { _Pragma("unroll") for (int n = 0; n < 2; ++n) _Pragma("unroll") for (int k = 0; k < 2; ++k) dst[n][k] = *(const LAS bf16x8*)(lds + PG8_SB(b, h) + boff + n * 2048 + k * 1024); } while (0)
#define PG8_MMA(ai, bj, At, Bt) do { __builtin_amdgcn_s_setprio(1); _Pragma("unroll") for (int m = 0; m < 4; ++m) _Pragma("unroll") for (int n = 0; n < 2; ++n) _Pragma("unroll") for (int k = 0; k < 2; ++k) \
        acc[ai][bj][m][n] = __builtin_amdgcn_mfma_f32_16x16x32_bf16(Bt[n][k], At[m][k], acc[ai][bj][m][n], 0, 0, 0); __builtin_amdgcn_s_setprio(0); } while (0)
#define PG8_WAIT_V(n) asm volatile("s_waitcnt vmcnt(" #n ")" ::: "memory")
#define PG8_WAIT_L(n) asm volatile("s_waitcnt lgkmcnt(" #n ")" ::: "memory")
#define PG8_BAR __builtin_amdgcn_s_barrier()
#define PG8_SCHED __builtin_amdgcn_sched_barrier(0)
    Unit cur, nxt; int ui = 0;
    if (!S.next(0, cur)) return;
    f32x4 acc[2][2][4][2];
#pragma unroll
    for (int a = 0; a < 2; ++a)
#pragma unroll
        for (int b = 0; b < 2; ++b)
#pragma unroll
            for (int m = 0; m < 4; ++m)
#pragma unroll
                for (int n = 0; n < 2; ++n) acc[a][b][m][n] = (f32x4){0.f, 0.f, 0.f, 0.f};
    bf16x8 At[4][2], B0[2][2], B1[2][2];
    const char* cA = (const char*)g.A + g.aoffs(cur.pm); const char* cB = (const char*)g.Bt + (size_t)cur.pn * tstep;
    PG8_STAGE(PG8_SB(0, 0), cB, voffB); PG8_STAGE(PG8_SB(0, 1), cB + hstep, voffB); PG8_STAGE(PG8_SA(0, 0), cA, voffA); PG8_STAGE(PG8_SA(0, 1), cA + hstepA, voffA);
    if (wr == 1) PG8_BAR;
    PG8_WAIT_V(2); PG8_BAR;
    PG8_STAGE(PG8_SB(1, 0), cB + kstep, voffB); PG8_STAGE(PG8_SA(1, 0), PG8_AK(cA, 1), voffA); PG8_STAGE(PG8_SB(1, 1), cB + hstep + kstep, voffB);
    PG8_WAIT_V(6); PG8_BAR;
    for (;;) {
        const bool has_next = S.next(ui + 1, nxt);
        const char* nA = has_next ? (const char*)g.A + g.aoffs(nxt.pm) : cA; const char* nB = has_next ? (const char*)g.Bt + (size_t)nxt.pn * tstep : cB;
        for (int t = 0; t < nt; t += 2) {
            const bool last = (t == nt - 2);
            const char* a1 = PG8_AK(cA, t + 1);
            const char* a2 = last ? nA : PG8_AK(cA, t + 2); const char* b2 = last ? nB : cB + (size_t)(t + 2) * kstep;
            const char* a3 = last ? PG8_AK(nA, 1) : PG8_AK(cA, t + 3); const char* b3 = b2 + kstep;
            PG8_LDB(B0, 0, 0); PG8_LDB(B1, 0, 1); PG8_SCHED; PG8_LDA(At, 0, 0); PG8_STAGE(PG8_SA(1, 1), a1 + hstepA, voffA);
            PG8_WAIT_V(8); PG8_WAIT_L(0); PG8_BAR; PG8_MMA(0, 0, At, B0); PG8_MMA(0, 1, At, B1); PG8_BAR; PG8_SCHED;
            PG8_LDA(At, 0, 1); PG8_STAGE(PG8_SB(0, 0), b2, voffB); PG8_STAGE(PG8_SB(0, 1), b2 + hstep, voffB); PG8_STAGE(PG8_SA(0, 0), a2, voffA);
            PG8_WAIT_V(8); PG8_WAIT_L(0); PG8_BAR; PG8_MMA(1, 0, At, B0); PG8_MMA(1, 1, At, B1); PG8_BAR; PG8_SCHED;
            PG8_LDB(B0, 1, 0); PG8_LDB(B1, 1, 1); PG8_SCHED; PG8_LDA(At, 1, 0); PG8_STAGE(PG8_SA(0, 1), a2 + hstepA, voffA);
            PG8_WAIT_V(8); PG8_WAIT_L(0); PG8_BAR; PG8_MMA(0, 0, At, B0); PG8_MMA(0, 1, At, B1); PG8_BAR; PG8_SCHED;
            PG8_LDA(At, 1, 1); PG8_STAGE(PG8_SB(1, 0), b3, voffB); PG8_STAGE(PG8_SB(1, 1), b3 + hstep, voffB); PG8_STAGE(PG8_SA(1, 0), a3, voffA);
            PG8_WAIT_V(8); PG8_WAIT_L(0); PG8_BAR; PG8_MMA(1, 0, At, B0); PG8_MMA(1, 1, At, B1); PG8_BAR; PG8_SCHED;
            if constexpr (Epi::MIDK) { if (t + 2 == split) { PG8_WAIT_V(0); E.mid(acc, cur, wr, wc, fr, fq); PG8_WAIT_V(0); PG8_SCHED; } }
        }
        if constexpr (ALIGN_EPI) { if (wr == 0) PG8_BAR; }
        E(acc, cur, wr, wc, fr, fq);
        if (!has_next) break;
#pragma unroll
        for (int a = 0; a < 2; ++a)
#pragma unroll
            for (int b = 0; b < 2; ++b)
#pragma unroll
                for (int m = 0; m < 4; ++m)
#pragma unroll
                    for (int n = 0; n < 2; ++n) acc[a][b][m][n] = (f32x4){0.f, 0.f, 0.f, 0.f};
        cur = nxt; cA = nA; cB = nB; ++ui;
        if constexpr (ALIGN_EPI) { if (wr == 1) PG8_BAR; }
    }
    PG8_WAIT_V(0);
    if constexpr (!ALIGN_EPI) { if (wr == 0) PG8_BAR; }
    PG8_BAR;
#undef PG8_AK
#undef PG8_SA
#undef PG8_SB
#undef PG8_STAGE
#undef PG8_LDA
#undef PG8_LDB
#undef PG8_MMA
#undef PG8_WAIT_V
#undef PG8_WAIT_L
#undef PG8_BAR
#undef PG8_SCHED
}
}

__device__ __forceinline__ void st16_wt(const __amdgpu_buffer_rsrc_t rs, const void* base, const void* p, const u32x4 v) {
    __builtin_amdgcn_raw_buffer_store_b128(v, rs, (unsigned)((const char*)p - (const char*)base), 0, 16); }
__device__ __forceinline__ void st8_wt(const __amdgpu_buffer_rsrc_t rs, const void* base, const void* p, const u32x2 v) {
    __builtin_amdgcn_raw_buffer_store_b64(v, rs, (unsigned)((const char*)p - (const char*)base), 0, 16); }
#define WS_RSRC(ws_) __builtin_amdgcn_make_buffer_rsrc((ws_), 0, 0x10000000, 0x00020000)
#define OUT_RSRC(o_) __builtin_amdgcn_make_buffer_rsrc((o_), 0, 0x04000000, 0x00020000)
typedef const f32x4 (&AccRef)[2][2][4][2];
__device__ __forceinline__ u32x4 pack8(const f32x4 a, const f32x4 b) { u32x4 w; w.x = cvt_pk_bf16(a[0], a[1]); w.y = cvt_pk_bf16(a[2], a[3]); w.z = cvt_pk_bf16(b[0], b[1]); w.w = cvt_pk_bf16(b[2], b[3]); return w; }
__device__ __forceinline__ void unpack8(const u32x4 w, float (&o)[8]) { o[0] = bf_lo(w.x); o[1] = bf_hi(w.x); o[2] = bf_lo(w.y); o[3] = bf_hi(w.y); o[4] = bf_lo(w.z); o[5] = bf_hi(w.z); o[6] = bf_lo(w.w); o[7] = bf_hi(w.w); }
__device__ __forceinline__ int real2pad(int R) { return (R >> 11) * LP + 64 + (R & 2047); }

struct EpiP1 {
    static constexpr bool MIDK = false;
    bf16_t *QA, *KA, *VA, *QB, *KVB, *HALO; unsigned char* WS;
    __device__ __forceinline__ void operator()(AccRef acc, const pg8::Unit& u, int wr, int wc, int fr, int fq) const {
        const __amdgpu_buffer_rsrc_t rs = __builtin_amdgcn_make_buffer_rsrc(WS, 0, 0x10000000, 0x00020000);
        const int seg = u.pn >> 2; bf16_t* base; int ld, c0;
        if (seg < 4) { base = seg == 0 ? QA : (seg == 1 ? KA : (seg == 2 ? VA : QB)); ld = 1024; c0 = (u.pn & 3) * 256; } else { base = KVB; ld = 512; c0 = (u.pn - 16) * 256; }
        const int col0 = c0 + wc * 32 + 8 * fq;
#pragma unroll
        for (int ai = 0; ai < 2; ++ai)
#pragma unroll
            for (int m = 0; m < 4; ++m) { const int row = u.pm * 256 + ai * 128 + wr * 64 + m * 16 + fr;
#pragma unroll
                for (int bj = 0; bj < 2; ++bj) { const u32x4 w = pack8(acc[ai][bj][m][0], acc[ai][bj][m][1]);
                    st16_wt(rs, WS, base + (size_t)row * ld + col0 + bj * 128, w);
                    if (m == 3) { if (seg < 3 && fr >= 13) st16_wt(rs, WS, HALO + ((size_t)(row >> 6) * 3 + (fr - 13)) * 3072 + seg * 1024 + col0 + bj * 128, w); } } }
    }
};
struct EpiP3 {
    static constexpr bool MIDK = false;
    bf16_t *YA, *YB, *GA, *GB; const float *SSQ, *normw, *bgate; unsigned char* WS;
    __device__ __forceinline__ void operator()(AccRef acc, const pg8::Unit& u, int wr, int wc, int fr, int fq) const {
        const __amdgpu_buffer_rsrc_t rsw = WS_RSRC(WS);
        const int seg = u.pn >> 2, c0 = (u.pn & 3) * 256, col0 = c0 + wc * 32 + 8 * fq;
        if (seg >= 2) {
            bf16_t* G = seg == 2 ? GA : GB; const float* bg = bgate + (seg - 2) * 1024;
            f32x4 bv[2][2];
#pragma unroll
            for (int bj = 0; bj < 2; ++bj) { bv[bj][0] = *(const f32x4*)(bg + col0 + bj * 128); bv[bj][1] = *(const f32x4*)(bg + col0 + bj * 128 + 4); }
#pragma unroll
            for (int ai = 0; ai < 2; ++ai)
#pragma unroll
                for (int m = 0; m < 4; ++m) { const int R = u.pm * 256 + ai * 128 + wr * 64 + m * 16 + fr;
#pragma unroll
                    for (int bj = 0; bj < 2; ++bj) { f32x4 v0 = acc[ai][bj][m][0] + bv[bj][0], v1 = acc[ai][bj][m][1] + bv[bj][1];
#pragma unroll
                        for (int e = 0; e < 4; ++e) { v0[e] = sigmoidf_(v0[e]); v1[e] = sigmoidf_(v1[e]); }
                        st16_wt(rsw, WS, G + (size_t)R * 1024 + col0 + bj * 128, pack8(v0, v1)); } }
        } else {
            bf16_t* Y = seg == 0 ? YA : YB;
            float nw[8];
#pragma unroll
            for (int e = 0; e < 8; ++e) nw[e] = seg == 0 ? normw[wc * 32 + 8 * fq + e] : 1.f;
#pragma unroll
            for (int ai = 0; ai < 2; ++ai)
#pragma unroll
                for (int m = 0; m < 4; ++m) { const int R = u.pm * 256 + ai * 128 + wr * 64 + m * 16 + fr; const int prow = real2pad(R);
#pragma unroll
                    for (int bj = 0; bj < 2; ++bj) {
                        float rs = 1.f;
                        if (seg == 0) { const int head = (u.pn & 3) * 2 + bj; const f32x4* sp = (const f32x4*)(SSQ + ((size_t)prow * 8 + head) * 8); const f32x4 s0 = sp[0], s1 = sp[1];
                            const float ss = (s0[0] + s0[1]) + (s0[2] + s0[3]) + (s1[0] + s1[1]) + (s1[2] + s1[3]); rs = rsqrtf(ss * (1.f / 128.f) + 1e-6f); }
                        bf16_t* p = Y + (size_t)prow * 1024 + col0 + bj * 128; const u32x4 ow = *(const u32x4*)p; float o[8]; unpack8(ow, o);
                        f32x4 v0, v1;
#pragma unroll
                        for (int e = 0; e < 4; ++e) { v0[e] = o[e] * rs * nw[e] * siluf_(acc[ai][bj][m][0][e]); v1[e] = o[4 + e] * rs * nw[4 + e] * siluf_(acc[ai][bj][m][1][e]); }
                        *(u32x4*)p = pack8(v0, v1); } }
        }
    }
};
struct EpiP4 {
    static constexpr bool MIDK = true;
    const bf16_t *GA, *GB; bf16_t* MIX; unsigned char* WS;
    __device__ __forceinline__ void mid(f32x4 (&acc)[2][2][4][2], const pg8::Unit& u, int wr, int wc, int fr_, int fq) const {
        int fr = fr_; asm volatile("" : "+v"(fr));
        const int col0 = u.pn * 256 + wc * 32 + 8 * fq;
#pragma unroll
        for (int ai = 0; ai < 2; ++ai)
#pragma unroll
            for (int m = 0; m < 4; ++m) { const size_t R = u.pm * 256 + ai * 128 + wr * 64 + m * 16 + fr;
#pragma unroll
                for (int bj = 0; bj < 2; ++bj) { const size_t off = R * 1024 + col0 + bj * 128; float ga[8], gb[8]; unpack8(*(const u32x4*)(GA + off), ga); unpack8(*(const u32x4*)(GB + off), gb);
#pragma unroll
                    for (int e = 0; e < 4; ++e) { acc[ai][bj][m][0][e] *= ga[e] * __builtin_amdgcn_rcpf(gb[e]); acc[ai][bj][m][1][e] *= ga[4 + e] * __builtin_amdgcn_rcpf(gb[4 + e]); } }
                asm volatile("" ::: "memory"); }
    }
    __device__ __forceinline__ void operator()(AccRef acc, const pg8::Unit& u, int wr, int wc, int fr, int fq) const {
        const int col0 = u.pn * 256 + wc * 32 + 8 * fq;
#pragma unroll
        for (int ai = 0; ai < 2; ++ai)
#pragma unroll
            for (int m = 0; m < 4; ++m) { const size_t R = u.pm * 256 + ai * 128 + wr * 64 + m * 16 + fr;
#pragma unroll
                for (int bj = 0; bj < 2; ++bj) { const size_t off = R * 1024 + col0 + bj * 128; float g[8]; unpack8(*(const u32x4*)(GB + off), g);
                    f32x4 v0, v1;
#pragma unroll
                    for (int e = 0; e < 4; ++e) { v0[e] = g[e] * acc[ai][bj][m][0][e]; v1[e] = g[4 + e] * acc[ai][bj][m][1][e]; }
                    st16_wt(WS_RSRC(WS), WS, MIX + off, pack8(v0, v1)); } }
    }
};
struct EpiP5 {
    static constexpr bool MIDK = false;
    const float* X; float* OUT;
    __device__ __forceinline__ void operator()(AccRef acc, const pg8::Unit& u, int wr, int wc, int fr, int fq) const {
        const int col0 = u.pn * 256 + wc * 32 + 8 * fq;
#pragma unroll
        for (int ai = 0; ai < 2; ++ai)
#pragma unroll
            for (int m = 0; m < 4; ++m) { const size_t R = u.pm * 256 + ai * 128 + wr * 64 + m * 16 + fr;
#pragma unroll
                for (int bj = 0; bj < 2; ++bj) { const size_t off = R * 1024 + col0 + bj * 128;
                    const f32x4 x0 = *(const f32x4*)(X + off), x1 = *(const f32x4*)(X + off + 4);
                    const f32x4 o0 = x0 * DN_ALPHA + acc[ai][bj][m][0], o1 = x1 * DN_ALPHA + acc[ai][bj][m][1];
                    *(f32x4*)(OUT + off) = o0; *(f32x4*)(OUT + off + 4) = o1; } }
    }
};

struct Args {
    const float *x, *meta, *w_in, *b_gate, *conv_w, *a_log, *dt_bias, *gdn_norm_w, *sinks, *w_proj_a, *w_proj_b, *w_out, *ln_w, *ln_b;
    float* out; unsigned char* ws;
};

__device__ __forceinline__ void transpose_item(const float* W, int ldw, int col0, bf16_t* WT, int row0, LAS float* scr, int item, int nblk, int lane, int ldt = 1024, int kc0 = 0) {
    const int kb = item / nblk, nb = item % nblk, k0 = 64 * kb, n0 = 32 * nb;
#pragma unroll 8
    for (int i = 0; i < 32; ++i) { const int kk = 2 * i + (lane >> 5); scr[kk * 33 + (lane & 31)] = W[(size_t)(k0 + kk) * ldw + col0 + n0 + (lane & 31)]; }
    LDS_WAIT(); asm volatile("" ::: "memory");
    const int c = lane & 7;
#pragma unroll
    for (int j = 0; j < 4; ++j) { const int n = (lane >> 3) + 8 * j; const LAS float* s = scr + (8 * c) * 33 + n;
        u32x4 o; o.x = cvt_pk_bf16(s[0 * 33], s[1 * 33]); o.y = cvt_pk_bf16(s[2 * 33], s[3 * 33]); o.z = cvt_pk_bf16(s[4 * 33], s[5 * 33]); o.w = cvt_pk_bf16(s[6 * 33], s[7 * 33]);
        st16_wt(__builtin_amdgcn_make_buffer_rsrc(WT, 0, 0x02000000, 0x00020000), WT, WT + (size_t)(row0 + n0 + n) * ldt + kc0 + k0 + 8 * c, o); }
    LDS_WAIT(); asm volatile("" ::: "memory");
}

__device__ __forceinline__ void phase0(const Args& a, LAS unsigned char* lds, int bid, int G) {
    const int tid = threadIdx.x, lane = tid & 63, wave = tid >> 6;
    const int gw = bid * 8 + wave, NGW = G * 8;
    bf16_t* WT1 = (bf16_t*)(a.ws + WS_WT1); bf16_t* WT2 = (bf16_t*)(a.ws + WS_WT2);
    bf16_t* WA = (bf16_t*)(a.ws + WS_WA); bf16_t* WB = (bf16_t*)(a.ws + WS_WB); bf16_t* WO = (bf16_t*)(a.ws + WS_WO);
    LAS float* scr = (LAS float*)(lds + wave * 8704);
    constexpr int I0 = 16 * 96, I1 = 16 * 48, I2 = 16 * 32, I3 = 16 * 96, I4 = 16 * 32;
    constexpr int NIT = I0 + I1 + I2 + I3 + 3 * I4;
    for (int it = gw; it < NIT; it += NGW) {
        int r = it;
        if (r < I0) { transpose_item(a.w_in, NWIN, 0, WT1, 0, scr, r, 96, lane); continue; } r -= I0;
        if (r < I1) { transpose_item(a.w_in, NWIN, 4112, WT1, 3072, scr, r, 48, lane); continue; } r -= I1;
        if (r < I2) { transpose_item(a.w_in, NWIN, 3072, WT2, 0, scr, r, 32, lane); continue; } r -= I2;
        if (r < I3) { transpose_item(a.w_in, NWIN, 5648, WT2, 1024, scr, r, 96, lane); continue; } r -= I3;
        if (r < I4) { transpose_item(a.w_proj_a, 1024, 0, WA, 0, scr, r, 32, lane, 2048, 0); continue; } r -= I4;
        if (r < I4) { transpose_item(a.w_proj_b, 1024, 0, WA, 0, scr, r, 32, lane, 2048, 1024); continue; } r -= I4;
        transpose_item(a.w_out, 1024, 0, WO, 0, scr, r, 32, lane);
    }
    __syncthreads();
    LAS float* wl = (LAS float*)lds;
    for (int i = tid; i < 1024 * 16; i += 512) { const int k = i >> 4, c = i & 15; const int slot = ((k >> 8) * 4 + (k & 3)) * 64 + ((k & 255) >> 2);
        wl[slot * 20 + c] = a.w_in[(size_t)k * NWIN + 4096 + c]; }
    __syncthreads();
    bf16_t* HB = (bf16_t*)a.out; float* BD = (float*)(a.ws + WS_BD);
    for (int row = gw; row < MP; row += NGW) {
        const int b = row / LP, tp = row - b * LP;
        u32x2* hb8 = (u32x2*)(HB + (size_t)row * 1024);
        if (tp < 48) {
#pragma unroll
            for (int j = 0; j < 4; ++j) st8_wt(OUT_RSRC(a.out), a.out, &hb8[lane + 64 * j], (u32x2){0u, 0u});
            if (lane < 16) BD[(size_t)row * 16 + lane] = 0.f;
            continue;
        }
        const float* src = tp < 64 ? a.meta + (size_t)(tp - 48) * 1024 : a.x + ((size_t)b * SEQ + (tp - 64)) * 1024;
        f32x4 v[4];
#pragma unroll
        for (int j = 0; j < 4; ++j) v[j] = ((const f32x4*)src)[lane + 64 * j];
#pragma unroll
        for (int j = 0; j < 4; ++j) st8_wt(OUT_RSRC(a.out), a.out, &hb8[lane + 64 * j], (u32x2){cvt_pk_bf16(v[j][0], v[j][1]), cvt_pk_bf16(v[j][2], v[j][3])});
        float acc[16];
#pragma unroll
        for (int c = 0; c < 16; ++c) acc[c] = 0.f;
#pragma unroll
        for (int j = 0; j < 4; ++j)
#pragma unroll
            for (int e = 0; e < 4; ++e) { const LAS f32x4* wp = (const LAS f32x4*)(wl + ((j * 4 + e) * 64 + lane) * 20); const float hv = v[j][e];
#pragma unroll
                for (int c4 = 0; c4 < 4; ++c4) { const f32x4 w4 = wp[c4];
#pragma unroll
                    for (int q = 0; q < 4; ++q) acc[4 * c4 + q] += hv * w4[q]; } }
        float t8[8], t4[4], t2[2], t1;
        { const bool hi = lane & 32;
#pragma unroll
          for (int i = 0; i < 8; ++i) { const float send = hi ? acc[i] : acc[8 + i], keep = hi ? acc[8 + i] : acc[i]; t8[i] = keep + __shfl_xor(send, 32); } }
        { const bool hi = lane & 16;
#pragma unroll
          for (int i = 0; i < 4; ++i) { const float send = hi ? t8[i] : t8[4 + i], keep = hi ? t8[4 + i] : t8[i]; t4[i] = keep + __shfl_xor(send, 16); } }
        { const bool hi = lane & 8;
#pragma unroll
          for (int i = 0; i < 2; ++i) { const float send = hi ? t4[i] : t4[2 + i], keep = hi ? t4[2 + i] : t4[i]; t2[i] = keep + __shfl_xor(send, 8); } }
        { const bool hi = lane & 4; const float send = hi ? t2[0] : t2[1], keep = hi ? t2[1] : t2[0]; t1 = keep + __shfl_xor(send, 4); }
        t1 += __shfl_xor(t1, 2); t1 += __shfl_xor(t1, 1);
        const int idx = ((lane >> 5) & 1) * 8 + ((lane >> 4) & 1) * 4 + ((lane >> 3) & 1) * 2 + ((lane >> 2) & 1);
        if ((lane & 3) == 0) BD[(size_t)row * 16 + idx] = t1;
    }
}

constexpr int P2_QS = 0, P2_KS = 17408, P2_VS = 34816, P2_KF = 68608, P2_AM = 102400, P2_XO = 119808, P2_GC = 137216, P2_BETA = 137472, P2_EGC = 137728, P2_SCL = 137984;
__device__ __forceinline__ void phase2a(const Args& a, LAS unsigned char* lds, int bid, int G) {
    bf16_t* QA = (bf16_t*)(a.ws + WS_QA); bf16_t* KA = (bf16_t*)(a.ws + WS_KA); bf16_t* VA = (bf16_t*)(a.ws + WS_VA);
    bf16_t* WBUF = (bf16_t*)(a.ws + WS_WBUF); bf16_t* ATT = (bf16_t*)(a.ws + WS_ATT); const bf16_t* HALO = (const bf16_t*)(a.ws + WS_HALO);
    const float* BD = (const float*)(a.ws + WS_BD); float* GL = (float*)(a.ws + WS_GL);
    unsigned praw[3][11]; f32x2 pcw[3][4]; float pbd[2];
#define P2_FETCH(it_) do { const int tl_ = threadIdx.x, ln_ = tl_ & 63, wv_ = tl_ >> 6; const int bh_ = (it_) / NCH, n_ = (it_) - bh_ * NCH, b_ = bh_ >> 3, h_ = bh_ & 7; \
        const int rb_ = b_ * LP + 64 * n_, gc_ = b_ * NCH + n_, col_ = h_ * 128 + 2 * ln_, r0_ = wv_ * 8; \
        _Pragma("unroll") for (int seg = 0; seg < 3; ++seg) { const bf16_t* src_ = seg == 0 ? QA : (seg == 1 ? KA : VA); \
            _Pragma("unroll") for (int t = 0; t < 11; ++t) { const int ri = r0_ - 3 + t; unsigned w_; \
                if (ri >= 0) w_ = *(const unsigned*)(src_ + (size_t)(rb_ + ri) * 1024 + col_); \
                else w_ = n_ > 0 ? *(const unsigned*)(HALO + ((size_t)(gc_ - 1) * 3 + t) * 3072 + seg * 1024 + col_) : 0u; \
                praw[seg][t] = w_; } \
            _Pragma("unroll") for (int j = 0; j < 4; ++j) pcw[seg][j] = *(const f32x2*)(a.conv_w + (size_t)j * 3072 + seg * 1024 + col_); } \
        pbd[0] = BD[(size_t)(rb_ + ln_) * 16 + h_]; pbd[1] = BD[(size_t)(rb_ + ln_) * 16 + 8 + h_]; } while (0)
    if (bid < 64 * NCH) P2_FETCH(bid);
    for (int item = bid; item < 64 * NCH; item += G) {
        int tid_ = threadIdx.x; asm volatile("" : "+v"(tid_));
        const int tid = tid_, lane = tid & 63, wave = tid >> 6, fr = lane & 15, fq = lane >> 4;
        int z; asm volatile("s_mov_b32 %0, 0" : "=s"(z));
        LAS unsigned char* ldz = lds + z;
        LAS bf16_t* Qs = (LAS bf16_t*)(ldz + P2_QS); LAS bf16_t* Ks = (LAS bf16_t*)(ldz + P2_KS); LAS float* Vs = (LAS float*)(ldz + P2_VS);
        LAS float* Am = (LAS float*)(ldz + P2_AM); LAS bf16_t* Xo = (LAS bf16_t*)(ldz + P2_XO);
        LAS float* GC = (LAS float*)(ldz + P2_GC); LAS float* BETA = (LAS float*)(ldz + P2_BETA); LAS float* EGC = (LAS float*)(ldz + P2_EGC);
        LAS float* RX = (LAS float*)(ldz + P2_VS); LAS float* SCL = (LAS float*)(ldz + P2_SCL); LAS float* UPD = (LAS float*)(ldz + P2_QS);
        const int bh = item / NCH, n = item - bh * NCH, b = bh >> 3, h = bh & 7;
        const int rowbase = b * LP + 64 * n, gchunk = b * NCH + n;
        {
            const int r0 = wave * 8;
#pragma unroll
            for (int seg = 0; seg < 3; ++seg) {
                float x0[11], x1[11];
#pragma unroll
                for (int t = 0; t < 11; ++t) { x0[t] = bf_lo(praw[seg][t]); x1[t] = bf_hi(praw[seg][t]); }
#pragma unroll
                for (int rr = 0; rr < 8; ++rr) {
                    float y0 = 0.f, y1 = 0.f;
#pragma unroll
                    for (int j = 0; j < 4; ++j) { y0 += pcw[seg][j][0] * x0[rr + j]; y1 += pcw[seg][j][1] * x1[rr + j]; }
                    y0 = siluf_(y0); y1 = siluf_(y1);
                    const int r = r0 + rr;
                    if (seg < 2) {
                        const float ss = wave_sum_dpp(y0 * y0 + y1 * y1);
                        const float sc = rsqrtf(ss + 1e-6f) * (seg == 0 ? 0.08838834764831845f : 1.f);
                        *(LAS unsigned*)((seg == 0 ? Qs : Ks) + r * 136 + 2 * lane) = cvt_pk_bf16(y0 * sc, y1 * sc);
                        if (seg == 1) *(LAS f32x2*)(RX + r * 264 + 128 + 2 * lane) = (f32x2){y0 * sc, y1 * sc};
                    } else { *(LAS f32x2*)(RX + r * 264 + 2 * lane) = (f32x2){y0, y1}; }
                }
            }
            if (wave == 7) {
                const float braw = pbd[0], araw = pbd[1];
                const float xx = araw + a.dt_bias[h];
                const float sp = xx > 20.f ? xx : log1pf(__expf(xx));
                float g = -__expf(a.a_log[h]) * sp;
                if (n == 0 && lane < 48) g = 0.f;
#pragma unroll
                for (int o = 1; o < 64; o <<= 1) { const float t = __shfl_up(g, o); if (lane >= o) g += t; }
                const float be = sigmoidf_(braw), eg = __expf(g);
                GC[lane] = g; BETA[lane] = be; EGC[lane] = eg; SCL[lane] = be; SCL[64 + lane] = be * eg;
            }
            { const int nit = item + G < 64 * NCH ? item + G : item; P2_FETCH(nit); }
        }
        __syncthreads();
        {
            const int mi = wave >> 1;
            bf16x8 kA[4], qA[4];
#pragma unroll
            for (int kk = 0; kk < 4; ++kk) { kA[kk] = *(const LAS bf16x8*)(Ks + (16 * mi + fr) * 136 + 32 * kk + 8 * fq); qA[kk] = *(const LAS bf16x8*)(Qs + (16 * mi + fr) * 136 + 32 * kk + 8 * fq); }
            const int i = 16 * mi + fr; const float gci = GC[i], bi = BETA[i];
#pragma unroll
            for (int jj = 0; jj < 2; ++jj) {
                const int nj = (wave & 1) * 2 + jj;
                bf16_t* ap = ATT + (size_t)item * 4096 + i * 64 + 16 * nj + 4 * fq;
                if (nj > mi) { *(u32x2*)ap = (u32x2){0u, 0u}; continue; }
                f32x4 ck = {0.f, 0.f, 0.f, 0.f}, cq = {0.f, 0.f, 0.f, 0.f};
#pragma unroll
                for (int kk = 0; kk < 4; ++kk) { const bf16x8 kB = *(const LAS bf16x8*)(Ks + (16 * nj + fr) * 136 + 32 * kk + 8 * fq);
                    ck = __builtin_amdgcn_mfma_f32_16x16x32_bf16(kB, kA[kk], ck, 0, 0, 0); cq = __builtin_amdgcn_mfma_f32_16x16x32_bf16(kB, qA[kk], cq, 0, 0, 0); }
                f32x4 am, at;
#pragma unroll
                for (int r = 0; r < 4; ++r) { const int j = 16 * nj + 4 * fq + r; const float d = j <= i ? __expf(gci - GC[j]) : 0.f;
                    am[r] = j < i ? bi * ck[r] * d : 0.f; at[r] = cq[r] * d; }
                *(LAS f32x4*)(Am + i * 68 + 16 * nj + 4 * fq) = am;
                *(u32x2*)ap = (u32x2){cvt_pk_bf16(at[0], at[1]), cvt_pk_bf16(at[2], at[3])};
            }
        }
        __syncthreads();
        {
            const int c = tid & 255; const bool solver = tid < 256;
            unsigned amv; asm volatile("v_mov_b32 %0, %1" : "=v"(amv) : "s"((unsigned)(size_t)Am));
            const LAS float* AmV = (const LAS float*)(size_t)amv;
            const LAS float* rscl = SCL + (c < 128 ? 0 : 64);
            LAS float* RXc = RX + c;
#pragma unroll
            for (int bi = 0; bi < 4; ++bi) {
                if (bi > 0) {
#pragma unroll
                    for (int t2 = 0; t2 < 2; ++t2) { const int ct = 2 * wave + t2; f32x4 acc = {0.f, 0.f, 0.f, 0.f};
#pragma unroll
                        for (int ks = 0; ks < 4 * bi; ++ks) acc = __builtin_amdgcn_mfma_f32_16x16x4f32(Am[(16 * bi + fr) * 68 + 4 * ks + fq], RX[(4 * ks + fq) * 264 + 16 * ct + fr], acc, 0, 0, 0);
#pragma unroll
                        for (int r = 0; r < 4; ++r) UPD[(4 * fq + r) * 260 + 16 * ct + fr] = acc[r]; }
                    __syncthreads();
                }
                if (solver) {
                    float xb[16];
#pragma unroll
                    for (int r = 0; r < 16; ++r) { xb[r] = rscl[16 * bi + r] * RXc[(16 * bi + r) * 264]; if (bi > 0) xb[r] -= UPD[r * 260 + c]; }
#pragma unroll
                    for (int j = 0; j < 15; ++j) {
#pragma unroll
                        for (int r = j + 1; r < 16; ++r) xb[r] -= AmV[(16 * bi + r) * 68 + 16 * bi + j] * xb[j];
                        if ((j & 3) == 3) asm volatile("" ::: "memory");
                    }
#pragma unroll
                    for (int r = 0; r < 16; ++r) RXc[(16 * bi + r) * 264] = xb[r];
                } else if (bi == 0) {
                    const int t = tid - 256;
#pragma unroll
                    for (int e4 = 0; e4 < 4; ++e4) { const int id = t + 256 * e4, i = id >> 4, cc = id & 15; float q[8]; unpack8(*(const LAS u32x4*)(Qs + i * 136 + 8 * cc), q); const float eg = EGC[i];
                        u32x4 w; w.x = cvt_pk_bf16(q[0] * eg, q[1] * eg); w.y = cvt_pk_bf16(q[2] * eg, q[3] * eg); w.z = cvt_pk_bf16(q[4] * eg, q[5] * eg); w.w = cvt_pk_bf16(q[6] * eg, q[7] * eg);
                        st16_wt(WS_RSRC(a.ws), a.ws, QA + (size_t)(rowbase + i) * 1024 + h * 128 + 8 * cc, w); }
                    const float gl = GC[63];
#pragma unroll
                    for (int e4 = 0; e4 < 4; ++e4) { const int id = t + 256 * e4, dk = id >> 3, ib = id & 7; float kv[8];
#pragma unroll
                        for (int e = 0; e < 8; ++e) { const int i = 8 * ib + e; kv[e] = bf2f(Ks[i * 136 + dk]) * __expf(gl - GC[i]); }
                        u32x4 w; w.x = cvt_pk_bf16(kv[0], kv[1]); w.y = cvt_pk_bf16(kv[2], kv[3]); w.z = cvt_pk_bf16(kv[4], kv[5]); w.w = cvt_pk_bf16(kv[6], kv[7]);
                        st16_wt(WS_RSRC(a.ws), a.ws, KA + (size_t)(rowbase + (dk >> 1)) * 1024 + h * 128 + (dk & 1) * 64 + 8 * ib, w); }
                    if (t == 0) GL[item] = __expf(gl);
                }
                if (bi < 3) __syncthreads();
            }
            if (solver) {
                if (c < 128) {
                    const int s32 = c & ~31, dvl = c & 31;
#pragma unroll
                    for (int q = 0; q < 8; ++q) { float x8[8];
#pragma unroll
                        for (int e = 0; e < 8; ++e) x8[e] = RXc[(8 * q + e) * 264];
                        u32x4 w; w.x = cvt_pk_bf16(x8[0], x8[1]); w.y = cvt_pk_bf16(x8[2], x8[3]); w.z = cvt_pk_bf16(x8[4], x8[5]); w.w = cvt_pk_bf16(x8[6], x8[7]);
                        *(u32x4*)(VA + (size_t)(rowbase + 2 * dvl + (q >> 2)) * 1024 + h * 128 + s32 + (q & 3) * 8) = w; }
                } else {
                    const int dk = c - 128;
#pragma unroll
                    for (int i = 0; i < 64; i += 2) { const unsigned w = cvt_pk_bf16(RXc[i * 264], RXc[(i + 1) * 264]); Xo[i * 136 + dk] = (bf16_t)(w & 0xffffu); Xo[(i + 1) * 136 + dk] = (bf16_t)(w >> 16); }
                }
            }
        }
        __syncthreads();
#pragma unroll
        for (int e2 = 0; e2 < 2; ++e2) { const int id = tid + 512 * e2, i = id >> 4, cc = id & 15;
            st16_wt(WS_RSRC(a.ws), a.ws, WBUF + (size_t)(rowbase + i) * 1024 + h * 128 + 8 * cc, *(const LAS u32x4*)(Xo + i * 136 + 8 * cc)); }
        __syncthreads();
    }
#undef P2_FETCH
}

constexpr int SC_ST = 0, SC_VT = 8704, SC_W = 13312, SC_Q = 30720, SC_K = 48128, SC_A = 66560, SC_U = 75776;
__device__ __forceinline__ void scan_item(const Args& a, LAS unsigned char* lds, int sid) {
    int tid_ = threadIdx.x; asm volatile("" : "+v"(tid_));
    const int tid = tid_, lane = tid & 63, wave = tid >> 6, fr = lane & 15, fq = lane >> 4;
    const int bh = (sid & 7) * 8 + (sid >> 5), s = (sid >> 3) & 3, b = bh >> 3, h = bh & 7;
    const bf16_t* QA = (const bf16_t*)(a.ws + WS_QA); const bf16_t* KA = (const bf16_t*)(a.ws + WS_KA); bf16_t* VA = (bf16_t*)(a.ws + WS_VA);
    const bf16_t* WBUF = (const bf16_t*)(a.ws + WS_WBUF); const bf16_t* ATT = (const bf16_t*)(a.ws + WS_ATT);
    const float* GL = (const float*)(a.ws + WS_GL); float* SSQ = (float*)(a.ws + WS_SSQ);
    LAS bf16_t* ST = (LAS bf16_t*)(lds + SC_ST);
    LAS bf16_t* VT = (LAS bf16_t*)(lds + SC_VT);
    const int mt = wave >> 1, nt = wave & 1, colh = h * 128;
    const int dvl = 16 * nt + fr, i0 = 16 * mt + 4 * fq;
    const int srow = tid >> 4, scc = tid & 15;
    const unsigned dW0 = SC_W + srow * 272 + scc * 16, dW1 = dW0 + 32 * 272, dQ0 = dW0 + (SC_Q - SC_W), dQ1 = dQ0 + 32 * 272;
    const unsigned dK0 = SC_K + (2 * srow + (scc >> 3)) * 144 + (scc & 7) * 16, dK1 = dK0 + 64 * 144;
    const unsigned dA = SC_A + (tid >> 3) * 144 + (tid & 7) * 16;
    const int urow = (tid & 255) >> 2, uc4 = tid & 3;
    const unsigned dU = SC_U + (urow >> 1) * 144 + (32 * (urow & 1) + 8 * uc4) * 2;
    u32x4 Ra[8], Rb[8];
#define SC_LOAD(R, n_) do { const int rb_ = b * LP + 64 * (n_); const size_t o0_ = (size_t)(rb_ + srow) * 1024 + colh + 8 * scc, o1_ = o0_ + 32 * 1024; \
        R[0] = *(const u32x4*)(WBUF + o0_); R[1] = *(const u32x4*)(WBUF + o1_); R[2] = *(const u32x4*)(QA + o0_); R[3] = *(const u32x4*)(QA + o1_); \
        R[4] = *(const u32x4*)(KA + o0_); R[5] = *(const u32x4*)(KA + o1_); R[6] = *(const u32x4*)(ATT + (size_t)(bh * NCH + (n_)) * 4096 + 8 * tid); \
        R[7] = *(const u32x4*)(VA + (size_t)(rb_ + urow) * 1024 + colh + 32 * s + 8 * uc4); } while (0)
#define SC_PARK(R) do { *(LAS u32x4*)(lds + dW0) = R[0]; *(LAS u32x4*)(lds + dW1) = R[1]; *(LAS u32x4*)(lds + dQ0) = R[2]; *(LAS u32x4*)(lds + dQ1) = R[3]; \
        *(LAS u32x4*)(lds + dK0) = R[4]; *(LAS u32x4*)(lds + dK1) = R[5]; *(LAS u32x4*)(lds + dA) = R[6]; if (tid < 256) *(LAS u32x4*)(lds + dU) = R[7]; } while (0)
    bf16x8 wA[4], qA[4], aA[2], kA[2]; u32x2 uw;
#define SC_FRAGS() do { \
        _Pragma("unroll") for (int kk = 0; kk < 4; ++kk) { wA[kk] = *(const LAS bf16x8*)(lds + SC_W + (16 * mt + fr) * 272 + (32 * kk + 8 * fq) * 2); qA[kk] = *(const LAS bf16x8*)(lds + SC_Q + (16 * mt + fr) * 272 + (32 * kk + 8 * fq) * 2); } \
        _Pragma("unroll") for (int kk = 0; kk < 2; ++kk) { aA[kk] = *(const LAS bf16x8*)(lds + SC_A + (16 * mt + fr) * 144 + (32 * kk + 8 * fq) * 2); kA[kk] = *(const LAS bf16x8*)(lds + SC_K + (16 * wave + fr) * 144 + (32 * kk + 8 * fq) * 2); } \
        uw = *(const LAS u32x2*)(lds + SC_U + dvl * 144 + i0 * 2); } while (0)
    for (int i = tid; i < 32 * 136 / 2; i += 512) ((LAS unsigned*)ST)[i] = 0u;
    f32x4 Sacc[2] = {{0.f, 0.f, 0.f, 0.f}, {0.f, 0.f, 0.f, 0.f}};
    SC_LOAD(Ra, 0); SC_PARK(Ra);
    __syncthreads();
    SC_FRAGS();
    float gl = GL[bh * NCH];
    __syncthreads();
    SC_LOAD(Ra, 1); SC_PARK(Ra);
    SC_LOAD(Ra, 2);
    for (int n = 0; n < NCH; ++n) {
        const int rowbase = b * LP + 64 * n;
        { const int nn = n + 3 < NCH ? n + 3 : NCH - 1; SC_LOAD(Rb, nn); }
        const float gN = GL[bh * NCH + (n + 1 < NCH ? n + 1 : n)];
        f32x4 a1 = {0.f, 0.f, 0.f, 0.f}, a2 = {0.f, 0.f, 0.f, 0.f};
#pragma unroll
        for (int kk = 0; kk < 4; ++kk) { const bf16x8 sf = *(const LAS bf16x8*)(ST + (16 * nt + fr) * 136 + 32 * kk + 8 * fq);
            a1 = __builtin_amdgcn_mfma_f32_16x16x32_bf16(wA[kk], sf, a1, 0, 0, 0); a2 = __builtin_amdgcn_mfma_f32_16x16x32_bf16(sf, qA[kk], a2, 0, 0, 0); }
        { const float v0 = bf_lo(uw.x) - a1[0], v1 = bf_hi(uw.x) - a1[1], v2 = bf_lo(uw.y) - a1[2], v3 = bf_hi(uw.y) - a1[3];
          *(LAS u32x2*)(VT + (16 * nt + fr) * 72 + 16 * mt + 4 * fq) = (u32x2){cvt_pk_bf16(v0, v1), cvt_pk_bf16(v2, v3)}; }
        __syncthreads();
#pragma unroll
        for (int kk = 0; kk < 2; ++kk) { const bf16x8 vf = *(const LAS bf16x8*)(VT + (16 * nt + fr) * 72 + 32 * kk + 8 * fq);
            a2 = __builtin_amdgcn_mfma_f32_16x16x32_bf16(vf, aA[kk], a2, 0, 0, 0); }
        { const int row = rowbase + 16 * mt + fr;
          *(u32x2*)(VA + (size_t)row * 1024 + colh + 32 * s + 16 * nt + 4 * fq) = (u32x2){cvt_pk_bf16(a2[0], a2[1]), cvt_pk_bf16(a2[2], a2[3])};
          float p = a2[0] * a2[0] + a2[1] * a2[1] + a2[2] * a2[2] + a2[3] * a2[3]; p += __shfl_xor(p, 16); p += __shfl_xor(p, 32);
          if (fq == 0) SSQ[((size_t)row * 8 + h) * 8 + s * 2 + nt] = p; }
#pragma unroll
        for (int n3 = 0; n3 < 2; ++n3) { Sacc[n3] = Sacc[n3] * gl;
#pragma unroll
            for (int kk = 0; kk < 2; ++kk) { const bf16x8 vf = *(const LAS bf16x8*)(VT + (16 * n3 + fr) * 72 + 32 * kk + 8 * fq);
                Sacc[n3] = __builtin_amdgcn_mfma_f32_16x16x32_bf16(kA[kk], vf, Sacc[n3], 0, 0, 0); }
            *(LAS u32x2*)(ST + (16 * n3 + fr) * 136 + 16 * wave + 4 * fq) = (u32x2){cvt_pk_bf16(Sacc[n3][0], Sacc[n3][1]), cvt_pk_bf16(Sacc[n3][2], Sacc[n3][3])}; }
        SC_FRAGS();
        gl = gN;
        __syncthreads();
        SC_PARK(Ra);
#pragma unroll
        for (int e = 0; e < 8; ++e) Ra[e] = Rb[e];
    }
    __syncthreads();
#undef SC_LOAD
#undef SC_PARK
#undef SC_FRAGS
}

__device__ __forceinline__ void swa_items(const Args& a, LAS unsigned char* lds, int bid, int G) {
    int tid = threadIdx.x, lane = tid & 63, wave = tid >> 6, fr = lane & 15, fq = lane >> 4;
    bf16_t* QB = (bf16_t*)(a.ws + WS_QB); const bf16_t* KVB = (const bf16_t*)(a.ws + WS_KVB);
    LAS bf16_t* KL = (LAS bf16_t*)lds;
    LAS bf16_t* VTL = (LAS bf16_t*)(lds + 29952);
    u32x4 kreg[4], vreg[4]; bf16x8 qf[2][2];
#define SWA_FETCH(idx_) do { const int b_ = (idx_) >> 7, rem_ = (idx_) & 127, n_ = 1 + (rem_ >> 2), kvh_ = rem_ & 3; \
        _Pragma("unroll") for (int e = 0; e < 4; ++e) { const int id = tid + 512 * e; kreg[e] = (u32x4){0u, 0u, 0u, 0u}; vreg[e] = (u32x4){0u, 0u, 0u, 0u}; \
            if (id < 208 * 8) { const int key = id >> 3, cc = id & 7; int row; bool valid = true; \
                if (key < 16) row = b_ * LP + 48 + key; else { const int jj = (key - 16) >> 6, c = (key - 16) & 63, j = n_ - 2 + jj; valid = j >= 1; row = b_ * LP + 64 * (j < 0 ? 0 : j) + c; } \
                if (valid) { kreg[e] = *(const u32x4*)(KVB + (size_t)row * 512 + kvh_ * 64 + 8 * cc); vreg[e] = *(const u32x4*)(KVB + (size_t)row * 512 + 256 + kvh_ * 64 + 8 * cc); } } } \
        { const int g_ = wave >> 1, half_ = wave & 1, head_ = kvh_ * 4 + g_, rb_ = b_ * LP + 64 * n_; \
          _Pragma("unroll") for (int mt = 0; mt < 2; ++mt) _Pragma("unroll") for (int kk = 0; kk < 2; ++kk) \
              qf[mt][kk] = *(const bf16x8*)(QB + (size_t)(rb_ + 32 * half_ + 16 * mt + fr) * 1024 + head_ * 64 + 32 * kk + 8 * fq); } } while (0)
    if (bid < 1024) SWA_FETCH(bid);
  for (int idx = bid; idx < 1024; idx += G) {
    tid = threadIdx.x; asm volatile("" : "+v"(tid)); lane = tid & 63; wave = tid >> 6; fr = lane & 15; fq = lane >> 4;
    const int b = idx >> 7, rem = idx & 127, n = 1 + (rem >> 2), kvh = rem & 3;
    const int rowbase = b * LP + 64 * n;
#pragma unroll
    for (int e = 0; e < 4; ++e) { const int id = tid + 512 * e;
        if (id < 208 * 8) { const int key = id >> 3, cc = id & 7; const u32x4 kw = kreg[e], vw = vreg[e];
            *(LAS u32x4*)(KL + key * 72 + 8 * cc) = kw;
            LAS bf16_t* vp = VTL + (8 * cc) * 232 + key;
            vp[0 * 232] = (bf16_t)(vw.x & 0xffffu); vp[1 * 232] = (bf16_t)(vw.x >> 16); vp[2 * 232] = (bf16_t)(vw.y & 0xffffu); vp[3 * 232] = (bf16_t)(vw.y >> 16);
            vp[4 * 232] = (bf16_t)(vw.z & 0xffffu); vp[5 * 232] = (bf16_t)(vw.z >> 16); vp[6 * 232] = (bf16_t)(vw.w & 0xffffu); vp[7 * 232] = (bf16_t)(vw.w >> 16); } }
    if (tid < 128) { const int r = tid >> 1, hh = tid & 1; *(LAS u32x4*)(VTL + r * 232 + 208 + 8 * hh) = (u32x4){0u, 0u, 0u, 0u}; }
    __syncthreads();
    {
        const int g = wave >> 1, half = wave & 1, head = kvh * 4 + g;
        const float slope2 = exp2f(-0.5f * (float)(head + 1)) * LOG2E, sink2 = a.sinks[head] * LOG2E;
        f32x4 sc[2][13];
#pragma unroll
        for (int kt = 0; kt < 13; ++kt) {
            const bf16x8 k0 = *(const LAS bf16x8*)(KL + (16 * kt + fr) * 72 + 8 * fq), k1 = *(const LAS bf16x8*)(KL + (16 * kt + fr) * 72 + 32 + 8 * fq);
#pragma unroll
            for (int mt = 0; mt < 2; ++mt) { f32x4 c = {0.f, 0.f, 0.f, 0.f};
                c = __builtin_amdgcn_mfma_f32_16x16x32_bf16(k0, qf[mt][0], c, 0, 0, 0); c = __builtin_amdgcn_mfma_f32_16x16x32_bf16(k1, qf[mt][1], c, 0, 0, 0); sc[mt][kt] = c; }
        }
        float mx[2], sm[2];
#pragma unroll
        for (int mt = 0; mt < 2; ++mt) {
            const int tq = 64 * n + 32 * half + 16 * mt + fr - 48;
            float m = sink2;
#pragma unroll
            for (int kt = 0; kt < 13; ++kt)
#pragma unroll
                for (int r = 0; r < 4; ++r) { const int sidx = 16 * kt + 4 * fq + r; int tk; bool valid = true;
                    if (kt == 0) tk = sidx; else { const int jj = (sidx - 16) >> 6, j = n - 2 + jj; valid = j >= 1; tk = 64 * j + ((sidx - 16) & 63) - 48; }
                    const int dd = tq - tk; const float dist = (float)(dd < 0 ? -dd : dd);
                    const float v = valid ? sc[mt][kt][r] * (0.125f * LOG2E) - slope2 * dist : -1e30f;
                    sc[mt][kt][r] = v; m = fmaxf(m, v); }
            m = fmaxf(m, __shfl_xor(m, 16)); m = fmaxf(m, __shfl_xor(m, 32));
            float ssum = 0.f;
#pragma unroll
            for (int kt = 0; kt < 13; ++kt)
#pragma unroll
                for (int r = 0; r < 4; ++r) { const float p = exp2f(sc[mt][kt][r] - m); sc[mt][kt][r] = p; ssum += p; }
            ssum += __shfl_xor(ssum, 16); ssum += __shfl_xor(ssum, 32);
            mx[mt] = m; sm[mt] = ssum + exp2f(sink2 - m);
        }
        f32x4 oacc[2][4];
#pragma unroll
        for (int mt = 0; mt < 2; ++mt)
#pragma unroll
            for (int nt = 0; nt < 4; ++nt) oacc[mt][nt] = (f32x4){0.f, 0.f, 0.f, 0.f};
#pragma unroll
        for (int kk = 0; kk < 7; ++kk) {
            bf16x8 pf[2];
#pragma unroll
            for (int mt = 0; mt < 2; ++mt) { u32x4 w; w.x = cvt_pk_bf16(sc[mt][2 * kk][0], sc[mt][2 * kk][1]); w.y = cvt_pk_bf16(sc[mt][2 * kk][2], sc[mt][2 * kk][3]);
                if (kk < 6) { w.z = cvt_pk_bf16(sc[mt][2 * kk + 1 < 13 ? 2 * kk + 1 : 12][0], sc[mt][2 * kk + 1 < 13 ? 2 * kk + 1 : 12][1]); w.w = cvt_pk_bf16(sc[mt][2 * kk + 1 < 13 ? 2 * kk + 1 : 12][2], sc[mt][2 * kk + 1 < 13 ? 2 * kk + 1 : 12][3]); }
                else { w.z = 0u; w.w = 0u; }
                pf[mt] = __builtin_bit_cast(bf16x8, w); }
#pragma unroll
            for (int nt = 0; nt < 4; ++nt) {
                const u32x2 v0 = *(const LAS u32x2*)(VTL + (16 * nt + fr) * 232 + 32 * kk + 4 * fq), v1 = *(const LAS u32x2*)(VTL + (16 * nt + fr) * 232 + 32 * kk + 16 + 4 * fq);
                const bf16x8 vf = __builtin_bit_cast(bf16x8, ((u32x4){v0.x, v0.y, v1.x, v1.y}));
#pragma unroll
                for (int mt = 0; mt < 2; ++mt) oacc[mt][nt] = __builtin_amdgcn_mfma_f32_16x16x32_bf16(vf, pf[mt], oacc[mt][nt], 0, 0, 0);
            }
        }
        { const int nidx = idx + G < 1024 ? idx + G : idx; SWA_FETCH(nidx); }
#pragma unroll
        for (int mt = 0; mt < 2; ++mt) { const float inv = 1.f / sm[mt]; (void)mx;
#pragma unroll
            for (int nt = 0; nt < 4; ++nt) { const f32x4 o = oacc[mt][nt] * inv;
                *(u32x2*)(QB + (size_t)(rowbase + 32 * half + 16 * mt + fr) * 1024 + head * 64 + 16 * nt + 4 * fq) = (u32x2){cvt_pk_bf16(o[0], o[1]), cvt_pk_bf16(o[2], o[3])}; } }
    }
    __syncthreads();
  }
#undef SWA_FETCH
}

__device__ __forceinline__ void phase6(const Args& a, int bid, int G) {
    const int tid = threadIdx.x, lane = tid & 63, wave = tid >> 6;
    const int gw = bid * 8 + wave, NGW = G * 8;
    f32x4 lw[4], lb[4];
#pragma unroll
    for (int j = 0; j < 4; ++j) { lw[j] = ((const f32x4*)a.ln_w)[lane + 64 * j]; lb[j] = ((const f32x4*)a.ln_b)[lane + 64 * j]; }
    for (int row = gw; row < MR; row += NGW) {
        f32x4* p = (f32x4*)(a.out + (size_t)row * 1024) + lane;
        f32x4 v[4]; float s = 0.f;
#pragma unroll
        for (int j = 0; j < 4; ++j) { v[j] = p[64 * j]; s += (v[j][0] + v[j][1]) + (v[j][2] + v[j][3]); }
        const float mean = wave_sum(s) * (1.f / 1024.f); float s2 = 0.f;
#pragma unroll
        for (int j = 0; j < 4; ++j) { v[j] = v[j] - mean; s2 += (v[j][0] * v[j][0] + v[j][1] * v[j][1]) + (v[j][2] * v[j][2] + v[j][3] * v[j][3]); }
        const float rstd = rsqrtf(wave_sum(s2) * (1.f / 1024.f) + 1e-5f);
#pragma unroll
        for (int j = 0; j < 4; ++j) p[64 * j] = v[j] * rstd * lw[j] + lb[j];
    }
}

#define XB_TMO      128
#define XB_XCNT(j)  (256  + 64 * (j))
#define XB_XSUB(j)  (1280 + 64 * (j))
#define XB_XGEN(j)  (2304 + 64 * (j))
#define XB_TOP      3328
#define XB_TOPGEN   3392
#define XCD_BAR_WORDS 3456
#define XB_SPIN_CAP (1u << 22)
__device__ __forceinline__ unsigned xb_ld(unsigned* p)              { return __hip_atomic_load(p, __ATOMIC_RELAXED, __HIP_MEMORY_SCOPE_AGENT); }
__device__ __forceinline__ unsigned xb_add(unsigned* p, unsigned v) { return __hip_atomic_fetch_add(p, v, __ATOMIC_RELAXED, __HIP_MEMORY_SCOPE_AGENT); }
__device__ __forceinline__ unsigned xb_xcc_id() { return (unsigned)__builtin_amdgcn_s_getreg((3 << 11) | 20) & 0xFu; }
#define XB_SPIN(cond, bar) do { unsigned _sp = 0; while (cond) { __builtin_amdgcn_s_sleep(1); \
    if ((++_sp & 255u) == 0u) { if (xb_ld(&(bar)[XB_TMO])) break; if (_sp > XB_SPIN_CAP) { atomicAdd(&(bar)[XB_TMO], 1u); break; } } } } while (0)
struct XcdBarrier { unsigned* bar; unsigned x; volatile LAS unsigned* st; };
__device__ __forceinline__ XcdBarrier xcd_barrier_post(unsigned* bar, volatile LAS unsigned* st) {
    XcdBarrier b; b.bar = bar; b.x = xb_xcc_id(); b.st = st;
    if (threadIdx.x == 0) (void)xb_add(&bar[XB_XCNT(b.x)], 1u);
    return b;
}
__device__ __forceinline__ void xcd_barrier_complete(unsigned* bar, unsigned x, unsigned& nloc, unsigned& nx) {
    const unsigned G = gridDim.x * gridDim.y * gridDim.z;
    unsigned sum, cnt, mine, sp = 0u;
    for (;;) {
        sum = 0u; cnt = 0u; mine = 0u;
#pragma unroll
        for (unsigned j = 0; j < 16; ++j) { const unsigned c = xb_ld(&bar[XB_XCNT(j)]); sum += c; cnt += (c > 0u) ? 1u : 0u; mine = (j == x) ? c : mine; }
        if (sum == G) break;
        __builtin_amdgcn_s_sleep(1);
        if ((++sp & 255u) == 0u) { if (xb_ld(&bar[XB_TMO])) break; if (sp > XB_SPIN_CAP) { atomicAdd(&bar[XB_TMO], 1u); break; } }
    }
    nloc = mine > 0u ? mine : 1u; nx = cnt > 0u ? cnt : 1u;
}
__device__ __forceinline__ void xcd_barrier(const XcdBarrier& b) {
    asm volatile("s_waitcnt vmcnt(0)" ::: "memory");
    __syncthreads();
    if (threadIdx.x == 0) {
        unsigned* bar = b.bar;
        __builtin_amdgcn_s_waitcnt(0);
        unsigned nloc = b.st[0], nx = b.st[1];
        if (nloc == 0u) { xcd_barrier_complete(bar, b.x, nloc, nx); b.st[0] = nloc; b.st[1] = nx; }
        const unsigned old = xb_add(&bar[XB_XSUB(b.x)], 1u);
        const unsigned gen = old / nloc;
        if (old + 1u == (gen + 1u) * nloc) {
            __builtin_amdgcn_fence(__ATOMIC_RELEASE, "agent");
            asm volatile("s_waitcnt vmcnt(0)" ::: "memory");
            const unsigned og = xb_add(&bar[XB_TOP], 1u);
            const unsigned tg = og / nx;
            if (og + 1u == (tg + 1u) * nx) xb_add(&bar[XB_TOPGEN], 1u);
            else XB_SPIN(xb_ld(&bar[XB_TOPGEN]) == tg, bar);
            __builtin_amdgcn_fence(__ATOMIC_ACQUIRE, "agent");
            xb_add(&bar[XB_XGEN(b.x)], 1u);
            asm volatile("s_waitcnt vmcnt(0)" ::: "memory");
        } else {
            XB_SPIN(xb_ld(&bar[XB_XGEN(b.x)]) == gen, bar);
            __builtin_amdgcn_fence(__ATOMIC_ACQUIRE, "agent");
            asm volatile("s_waitcnt vmcnt(0)" ::: "memory");
        }
    }
    __syncthreads();
}
__global__ void __launch_bounds__(512, 2) hybrid_fwd(Args a) {
    extern __shared__ __attribute__((aligned(16))) unsigned char lds_raw[];
    LAS unsigned char* lds = (LAS unsigned char*)lds_raw;
    cg::grid_group grid = cg::this_grid();
    const int G = gridDim.x, bid = blockIdx.x;
    volatile LAS unsigned* bst = (volatile LAS unsigned*)(lds + LDS_BYTES - 64);
    if (threadIdx.x < 16) bst[threadIdx.x] = 0u;
    __syncthreads();
    XcdBarrier bar = xcd_barrier_post((unsigned*)(a.ws + WS_CTL), bst);
    grid.sync();
    bf16_t* HB = (bf16_t*)a.out;
    bf16_t* QA = (bf16_t*)(a.ws + WS_QA); bf16_t* KA = (bf16_t*)(a.ws + WS_KA); bf16_t* VA = (bf16_t*)(a.ws + WS_VA); bf16_t* QB = (bf16_t*)(a.ws + WS_QB);
    bf16_t* KVB = (bf16_t*)(a.ws + WS_KVB); bf16_t* WBUF = (bf16_t*)(a.ws + WS_WBUF);

#ifndef ONLY
#define ONLY -1
#endif
#define PH(k) (ONLY < 0 || ONLY == (k))
    if (PH(0)) phase0(a, lds, bid, G);
    xcd_barrier(bar);
    if (PH(1)) {
        pg8::Gemm g{HB, (const bf16_t*)(a.ws + WS_WT1), MP, 4608, 1024, 0, HB, 1024, 16}; pg8::StaticOrder S; S.init(MP, 4608, G, bid);
        EpiP1 E{QA, KA, VA, QB, KVB, (bf16_t*)(a.ws + WS_HALO), a.ws};
        pg8::gemm_phase<EpiP1, true>(lds, g, S, E);
    }
    xcd_barrier(bar);
    if (PH(2)) phase2a(a, lds, bid, G);
    xcd_barrier(bar);
    if (PH(3)) for (int sid = bid; sid < 256; sid += G) scan_item(a, lds, sid);
    if (PH(4)) swa_items(a, lds, bid, G);
    xcd_barrier(bar);
#ifdef DIAG
    {
        const bf16_t* B0 = (const bf16_t*)(a.ws + (DIAG == 1 ? WS_VA : DIAG == 2 ? WS_QB : DIAG == 3 ? WS_QA : DIAG == 4 ? WS_KA : DIAG == 5 ? WS_WBUF : WS_VA));
        for (size_t i = (size_t)bid * 512 + threadIdx.x; i < (size_t)MR * 1024; i += (size_t)G * 512) { const int R = (int)(i >> 10), c = (int)(i & 1023); float v = bf2f(B0[(size_t)real2pad(R) * 1024 + c]);
            if (DIAG == 6) { v = bf2f(((const bf16_t*)(a.ws + WS_QA))[(size_t)real2pad(R) * 1024 + c]) + 2.f * bf2f(((const bf16_t*)(a.ws + WS_KA))[(size_t)real2pad(R) * 1024 + c]);
                if (i < (size_t)2112 * 4096) v += 4.f * bf2f(((const bf16_t*)(a.ws + WS_ATT))[i]); if (i < 2112) v += ((const float*)(a.ws + WS_GL))[i]; }
            a.out[i] = v; }
        return;
    }
#endif
    if (PH(5)) {
        pg8::Gemm g{HB, (const bf16_t*)(a.ws + WS_WT2), MR, 4096, 1024, 1, HB, 1024, 16}; pg8::StaticOrder S; S.init(MR, 4096, G, bid);
        EpiP3 E{VA, QB, QA, KA, (const float*)(a.ws + WS_SSQ), a.gdn_norm_w, a.b_gate, a.ws};
        pg8::gemm_phase<EpiP3, true>(lds, g, S, E);
    }
    xcd_barrier(bar);
    if (PH(6)) {
        pg8::StaticOrder S; S.init(MR, 1024, G, bid);
        pg8::Gemm g{VA, (const bf16_t*)(a.ws + WS_WA), MR, 1024, 2048, 1, QB, 1024, 16};
        EpiP4 E{QA, KA, WBUF, a.ws};
        pg8::gemm_phase<EpiP4, true>(lds, g, S, E);
    }
    xcd_barrier(bar);
    if (PH(7)) {
        pg8::Gemm g{WBUF, (const bf16_t*)(a.ws + WS_WO), MR, 1024, 1024, 0, WBUF, 1024, 16}; pg8::StaticOrder S; S.init(MR, 1024, G, bid);
        EpiP5 E{a.x, a.out};
        pg8::gemm_phase<EpiP5, true>(lds, g, S, E);
    }
    xcd_barrier(bar);
    if (PH(8)) phase6(a, bid, G);
}

extern "C" void kernel_launch(void* const* d_in, const int* in_sizes, int n_in, void* d_out, int out_size, void* d_ws, size_t ws_size, hipStream_t stream) {
    static int grid = 0;
    if (grid == 0) {
        if (n_in != 14 || ws_size < WS_CTL + CTL_BYTES) { fprintf(stderr, "kernel_launch: unexpected inputs (n_in %d, ws %zu)\n", n_in, ws_size); grid = -1; return; }
        int dev = 0, cus = 0, per_cu = 0;
        hipGetDevice(&dev); hipDeviceGetAttribute(&cus, hipDeviceAttributeMultiprocessorCount, dev);
        hipFuncSetAttribute((const void*)hybrid_fwd, hipFuncAttributeMaxDynamicSharedMemorySize, LDS_BYTES);
        hipOccupancyMaxActiveBlocksPerMultiprocessor(&per_cu, (const void*)hybrid_fwd, 512, LDS_BYTES);
        if (per_cu < 1) { fprintf(stderr, "kernel_launch: occupancy query reports %d blocks per CU\n", per_cu); per_cu = 1; }
        grid = cus;
        fprintf(stderr, "kernel_launch: cus %d per_cu %d grid %d\n", cus, per_cu, grid);
    }
    if (grid < 0) return;
    Args a{};
    a.x = (const float*)d_in[0]; a.meta = (const float*)d_in[1]; a.w_in = (const float*)d_in[2]; a.b_gate = (const float*)d_in[3]; a.conv_w = (const float*)d_in[4];
    a.a_log = (const float*)d_in[5]; a.dt_bias = (const float*)d_in[6]; a.gdn_norm_w = (const float*)d_in[7]; a.sinks = (const float*)d_in[8];
    a.w_proj_a = (const float*)d_in[9]; a.w_proj_b = (const float*)d_in[10]; a.w_out = (const float*)d_in[11]; a.ln_w = (const float*)d_in[12]; a.ln_b = (const float*)d_in[13];
    a.out = (float*)d_out; a.ws = (unsigned char*)d_ws;
    if (hipMemsetAsync((char*)d_ws + WS_CTL, 0, CTL_BYTES, stream) != hipSuccess) { fprintf(stderr, "kernel_launch: memset failed\n"); return; }
    void* args[] = {&a};
    hipError_t e = hipLaunchCooperativeKernel((const void*)hybrid_fwd, dim3(grid), dim3(512), args, LDS_BYTES, stream);
    if (e != hipSuccess) fprintf(stderr, "cooperative launch failed: %s (grid %d)\n", hipGetErrorString(e), grid);
}
```
